# Optimizing an MI355X kernel written in HIP

```python
import jax, jax.numpy as jnp
from jax import lax
import numpy as np

D_MODEL = 2048
BATCH = 8
SEQ = 2048
DEPTH = 4

CHUNK = 64
QBLK = 128
EPS = 1e-6
A_HEADS = 8
A_NOPE = 128
A_ROPE = 64
A_VDIM = 128
A_QLORA = 512
A_KVLORA = 256
ROPE_THETA = 10000.0
B_HEADS = 8
B_HDIM = 128
B_PREV = 8
B_BAND = (B_PREV + 1) * CHUNK
REL_CLIP = 128
SG_WIDTH = D_MODEL
SG_GROUPS = 8
SG_LEN = 128
A_WIDTH = A_HEADS * A_VDIM
B_WIDTH = B_HEADS * B_HDIM
AB_WIDTH = A_WIDTH + B_WIDTH
AB_IN = A_QLORA + A_KVLORA + A_ROPE + 3 * B_WIDTH + AB_WIDTH
N_EVEN = (DEPTH + 1) // 2
N_ODD = DEPTH // 2

kernel_name = "hybrid_mla_bandattn_gmlp_sandwich_adaln"


def rmsnorm(x, g):
    xf = x.astype(jnp.float32)
    y = xf * lax.rsqrt(jnp.mean(xf * xf, axis=-1, keepdims=True) + EPS)
    return y.astype(x.dtype) * g


def layernorm(x, g, b):
    xf = x.astype(jnp.float32)
    mu = jnp.mean(xf, axis=-1, keepdims=True)
    var = jnp.mean(jnp.square(xf - mu), axis=-1, keepdims=True)
    return ((xf - mu) * lax.rsqrt(var + EPS)).astype(x.dtype) * g + b


def rope(x, pos):
    half = x.shape[-1] // 2
    freqs = ROPE_THETA ** (-jnp.arange(half, dtype=jnp.float32) / half)
    ang = pos[:, None] * freqs[None, :]
    cos = jnp.cos(ang)[:, None, :].astype(x.dtype)
    sin = jnp.sin(ang)[:, None, :].astype(x.dtype)
    x1, x2 = x[..., :half], x[..., half:]
    return jnp.concatenate([x1 * cos - x2 * sin, x1 * sin + x2 * cos], axis=-1)


def chunk_causal_attention(q, k, v):
    bsz, s_len, h, dk = q.shape
    nb = s_len // QBLK
    scale = dk ** -0.5
    qb = q.reshape(bsz, nb, QBLK, h, dk).swapaxes(0, 1)
    kchunk = jnp.arange(s_len) // CHUNK

    def one(args):
        qi, i = args
        s = jnp.einsum('bqhd,bkhd->bhqk', qi, k, preferred_element_type=jnp.float32) * scale
        qchunk = (i * QBLK + jnp.arange(QBLK)) // CHUNK
        mask = kchunk[None, :] <= qchunk[:, None]
        p = jax.nn.softmax(jnp.where(mask, s, -jnp.inf), axis=-1)
        return jnp.einsum('bhqk,bkhd->bqhd', p.astype(v.dtype), v)

    o = lax.map(one, (qb, jnp.arange(nb)))
    return o.swapaxes(0, 1).reshape(bsz, s_len, h, v.shape[-1])


def chunk_band_attention(q, k, v, rel_table):
    bsz, s_len, h, d = q.shape
    nc = s_len // CHUNK
    scale = d ** -0.5
    pad = ((0, 0), (B_PREV * CHUNK, 0), (0, 0), (0, 0))
    kp = jnp.pad(k, pad)
    vp = jnp.pad(v, pad)
    rel = (B_PREV * CHUNK + jnp.arange(CHUNK))[:, None] - jnp.arange(B_BAND)[None, :]
    bias = rel_table[:, jnp.clip(rel, -REL_CLIP, REL_CLIP) + REL_CLIP].astype(jnp.float32)

    def one(i):
        qi = lax.dynamic_slice_in_dim(q, i * CHUNK, CHUNK, axis=1)
        kb = lax.dynamic_slice_in_dim(kp, i * CHUNK, B_BAND, axis=1)
        vb = lax.dynamic_slice_in_dim(vp, i * CHUNK, B_BAND, axis=1)
        s = jnp.einsum('bqhd,bkhd->bhqk', qi, kb, preferred_element_type=jnp.float32) * scale + bias[None]
        valid = (i - B_PREV) * CHUNK + jnp.arange(B_BAND) >= 0
        p = jax.nn.softmax(jnp.where(valid[None, None, None, :], s, -jnp.inf), axis=-1)
        return jnp.einsum('bhqk,bkhd->bqhd', p.astype(vb.dtype), vb)

    o = lax.map(one, jnp.arange(nc))
    return o.swapaxes(0, 1).reshape(bsz, s_len, h, d)


def mla_band_mixer(h, w_in, g_q, w_uq, g_kv, w_ukv, rel_table, w_out, pos):
    bsz, s_len, _ = h.shape
    z = h @ w_in
    o1 = A_QLORA
    o2 = o1 + A_KVLORA
    o3 = o2 + A_ROPE
    o4 = o3 + B_WIDTH
    o5 = o4 + B_WIDTH
    o6 = o5 + B_WIDTH
    cq, ckv, kr, bq, bk, bv, gate = jnp.split(z, [o1, o2, o3, o4, o5, o6], axis=-1)
    q = (rmsnorm(cq, g_q) @ w_uq).reshape(bsz, s_len, A_HEADS, A_NOPE + A_ROPE)
    q = jnp.concatenate([q[..., :A_NOPE], rope(q[..., A_NOPE:], pos)], axis=-1)
    kv = (rmsnorm(ckv, g_kv) @ w_ukv).reshape(bsz, s_len, A_HEADS, A_NOPE + A_VDIM)
    kr = rope(kr[:, :, None, :], pos)
    k = jnp.concatenate([kv[..., :A_NOPE], jnp.broadcast_to(kr, (bsz, s_len, A_HEADS, A_ROPE))], axis=-1)
    oa = chunk_causal_attention(q, k, kv[..., A_NOPE:]).reshape(bsz, s_len, A_WIDTH)
    shp = (bsz, s_len, B_HEADS, B_HDIM)
    ob = chunk_band_attention(bq.reshape(shp), bk.reshape(shp), bv.reshape(shp), rel_table)
    ob = ob.reshape(bsz, s_len, B_WIDTH)
    y = jnp.concatenate([oa, ob], axis=-1) * jax.nn.silu(gate)
    return y @ w_out


def spatial_gating_mixer(h, w_in, ln_g, ln_b, w_s, b_s, w_out):
    bsz, s_len, _ = h.shape
    u, v, gate = jnp.split(h @ w_in, 3, axis=-1)
    v = layernorm(v, ln_g, ln_b)
    n = s_len // SG_LEN
    dg = SG_WIDTH // SG_GROUPS
    v = v.reshape(bsz, n, SG_LEN, SG_GROUPS, dg)
    cpos = jnp.arange(SG_LEN) // CHUNK
    mask = cpos[None, :] <= cpos[:, None]
    ws = jnp.where(mask[None], w_s, jnp.zeros((), w_s.dtype))
    sv = jnp.einsum('gij,bnjgd->bnigd', ws, v) + b_s.T[:, :, None]
    y = u * sv.reshape(bsz, s_len, SG_WIDTH) * jax.nn.silu(gate)
    return y @ w_out


def setup_inputs(seed: int = 0) -> dict:
    key = jax.random.key(seed)
    ks = jax.random.split(key, 20)
    f32 = jnp.float32
    nrm = lambda k, shp, s: jax.random.normal(k, shp, f32) * s
    return {
        "x": nrm(ks[0], (BATCH, SEQ, D_MODEL), 1.0),
        "c": nrm(ks[1], (BATCH, D_MODEL), 1.0),
        "w_mod": nrm(ks[2], (DEPTH, D_MODEL, 3 * D_MODEL), 0.5 * D_MODEL ** -0.5),
        "b_mod": nrm(ks[3], (DEPTH, 3 * D_MODEL), 0.01),
        "g_pre": 1.0 + nrm(ks[4], (DEPTH, D_MODEL), 0.05),
        "g_post": 1.0 + nrm(ks[5], (DEPTH, D_MODEL), 0.05),
        "ab_w_in": nrm(ks[6], (N_EVEN, D_MODEL, AB_IN), D_MODEL ** -0.5),
        "a_g_q": 1.0 + nrm(ks[7], (N_EVEN, A_QLORA), 0.05),
        "a_w_uq": nrm(ks[8], (N_EVEN, A_QLORA, A_HEADS * (A_NOPE + A_ROPE)), A_QLORA ** -0.5),
        "a_g_kv": 1.0 + nrm(ks[9], (N_EVEN, A_KVLORA), 0.05),
        "a_w_ukv": nrm(ks[10], (N_EVEN, A_KVLORA, A_HEADS * (A_NOPE + A_VDIM)), A_KVLORA ** -0.5),
        "b_rel_bias": nrm(ks[11], (N_EVEN, B_HEADS, 2 * REL_CLIP + 1), 0.5),
        "ab_w_out": nrm(ks[12], (N_EVEN, AB_WIDTH, D_MODEL), AB_WIDTH ** -0.5),
        "sg_w_in": nrm(ks[13], (N_ODD, D_MODEL, 3 * SG_WIDTH), D_MODEL ** -0.5),
        "sg_ln_g": 1.0 + nrm(ks[14], (N_ODD, SG_WIDTH), 0.05),
        "sg_ln_b": nrm(ks[15], (N_ODD, SG_WIDTH), 0.01),
        "sg_w_s": nrm(ks[16], (N_ODD, SG_GROUPS, SG_LEN, SG_LEN), 0.5 * SG_LEN ** -0.5),
        "sg_b_s": 1.0 + nrm(ks[17], (N_ODD, SG_GROUPS, SG_LEN), 0.05),
        "sg_w_out": nrm(ks[18], (N_ODD, SG_WIDTH, D_MODEL), SG_WIDTH ** -0.5),
    }


def reference(x, c, w_mod, b_mod, g_pre, g_post, ab_w_in, a_g_q, a_w_uq, a_g_kv, a_w_ukv,
              b_rel_bias, ab_w_out, sg_w_in, sg_ln_g, sg_ln_b, sg_w_s, sg_b_s, sg_w_out):
    pos = jnp.arange(x.shape[1], dtype=jnp.float32)
    cs = jax.nn.silu(c)
    for l in range(DEPTH):
        mod = cs @ w_mod[l] + b_mod[l]
        shift, scale, gate = jnp.split(mod[:, None, :], 3, axis=-1)
        h = rmsnorm(x, g_pre[l]) * (1 + scale) + shift
        i = l // 2
        if l % 2 == 0:
            y = mla_band_mixer(h, ab_w_in[i], a_g_q[i], a_w_uq[i], a_g_kv[i], a_w_ukv[i],
                               b_rel_bias[i], ab_w_out[i], pos)
        else:
            y = spatial_gating_mixer(h, sg_w_in[i], sg_ln_g[i], sg_ln_b[i], sg_w_s[i],
                                     sg_b_s[i], sg_w_out[i])
        x = x + gate * rmsnorm(y, g_post[l])
    return x
```

```cpp
#include <hip/hip_runtime.h>
#include <hip/hip_cooperative_groups.h>
#include <cstdio>
namespace cg = cooperative_groups;
#define REP_GEMM 1
#define PROBE_ATTN_MODE 0
#define REP_MISC 1
#define REP_PREP 1

#define LAS __attribute__((address_space(3)))
#define DI __device__ __forceinline__
typedef unsigned short bf16_t;
typedef short bf16x8 __attribute__((ext_vector_type(8)));
typedef float f32x4 __attribute__((ext_vector_type(4)));
typedef float f32x16 __attribute__((ext_vector_type(16)));
typedef float f32x2 __attribute__((ext_vector_type(2)));
typedef __bf16 bf16x2_t __attribute__((ext_vector_type(2)));
typedef unsigned u32x4 __attribute__((ext_vector_type(4)));
typedef unsigned u32x2 __attribute__((ext_vector_type(2)));

DI unsigned pk2(float lo, float hi) { f32x2 v = {lo, hi}; return __builtin_bit_cast(unsigned, __builtin_convertvector(v, bf16x2_t)); }
DI float bflo(unsigned u) { return __uint_as_float(u << 16); }
DI float bfhi(unsigned u) { return __uint_as_float(u & 0xffff0000u); }
DI float bf1(unsigned short s) { return __uint_as_float(((unsigned)s) << 16); }
DI float silu_f(float x) { return x * __builtin_amdgcn_rcpf(1.0f + __builtin_amdgcn_exp2f(-1.44269504f * x)); }
DI int get_tid() { int t = threadIdx.x; asm volatile("" : "+v"(t)); return t; }
DI float max3f(float a, float b, float c) { return __builtin_amdgcn_fmed3f(__builtin_amdgcn_fmed3f(a, b, __builtin_inff()), c, __builtin_inff()); }
DI float wave_sum(float v) {
#pragma unroll
  for (int o = 32; o > 0; o >>= 1) v += __shfl_xor(v, o);
  return v;
}

constexpr int T = 16384, DM = 2048, SEQ = 2048;
constexpr float EPS = 1e-6f;
constexpr float LOG2E = 1.44269504088896f;

constexpr size_t E_WIN = 0, E_WBV = E_WIN + (size_t)5120 * 2048, E_WUQ = E_WBV + (size_t)1024 * 2048, E_WKN = E_WUQ + (size_t)1536 * 512,
                 E_WV = E_WKN + (size_t)1024 * 256, E_WOUT = E_WV + (size_t)1024 * 256, EVEN_SZ = E_WOUT + (size_t)2048 * 2048;
constexpr size_t O_WUG = 0, O_WV = O_WUG + (size_t)4096 * 2048, O_WOUT = O_WV + (size_t)2048 * 2048, ODD_SZ = O_WOUT + (size_t)2048 * 2048;
constexpr size_t W_TOTAL = 2 * EVEN_SZ + 2 * ODD_SZ;
constexpr size_t al256(size_t x) { return (x + 255) & ~(size_t)255; }
constexpr size_t B_W = 0;
constexpr size_t B_MOD = al256(B_W + W_TOTAL * 2);
constexpr size_t B_COS = al256(B_MOD + (size_t)4 * 8 * 6144 * 4);
constexpr size_t B_SIN = al256(B_COS + (size_t)2048 * 32 * 4);
constexpr size_t B_H = al256(B_SIN + (size_t)2048 * 32 * 4);
constexpr size_t B_Z = al256(B_H + (size_t)T * 2048 * 2);
constexpr size_t B_VT = al256(B_Z + (size_t)T * 5120 * 2);
constexpr size_t B_Q = al256(B_VT + (size_t)2048 * T * 2);
constexpr size_t B_KN = al256(B_Q + (size_t)T * 1536 * 2);
constexpr size_t B_KR = al256(B_KN + (size_t)T * 1024 * 2);
constexpr size_t B_ST0 = al256(B_KR + (size_t)T * 64 * 2);
constexpr size_t B_ST1 = al256(B_ST0 + (size_t)T * 4);
constexpr size_t B_Y = al256(B_ST1 + (size_t)T * 4);
constexpr size_t B_XB = al256(B_Y + (size_t)T * 2048 * 2);
constexpr size_t B_BAR = al256(B_XB + (size_t)T * 2048 * 2);
constexpr size_t B_CTR = B_BAR + 16384;
constexpr size_t ZERO_BYTES = 16384 + 256;
constexpr size_t WS_NEED = B_CTR + 256;

struct Params { const float* in[19]; float* out; unsigned char* ws; };
typedef const __attribute__((address_space(4))) Params* KP;

struct Seg { int in_idx; long src_off; int ld; int K; int nrows; long dst_off; int sc_idx; int sc_off; int tile0; int split; };
constexpr int NSEG_MAX = 64;
struct SegTab { Seg s[NSEG_MAX]; int n; int ntiles; };
constexpr SegTab make_segtab() {
  SegTab t{};
  int n = 0;
  for (int e = 0; e < 2; ++e) {
    const long WE = (long)(e * EVEN_SZ);
    const long so = (long)e * 2048 * 5952;
    t.s[n++] = Seg{6, so + 0, 5952, 2048, 832, WE + (long)E_WIN, -1, 0, 0};
    t.s[n++] = Seg{-1, 0, 5952, 2048, 192, WE + (long)E_WIN + 832L * 2048, -1, 0, 0};
    t.s[n++] = Seg{6, so + 832, 5952, 2048, 2048, WE + (long)E_WIN + 1024L * 2048, -1, 0, 0};
    t.s[n++] = Seg{6, so + 3904, 5952, 2048, 2048, WE + (long)E_WIN + 3072L * 2048, -1, 0, 0};
    t.s[n++] = Seg{6, so + 2880, 5952, 2048, 1024, WE + (long)E_WBV, -1, 0, 0};
    t.s[n++] = Seg{8, (long)e * 512 * 1536, 1536, 512, 1536, WE + (long)E_WUQ, 7, e * 512, 0};
    for (int hh = 0; hh < 8; ++hh) {
      t.s[n++] = Seg{10, (long)e * 256 * 2048 + hh * 256, 2048, 256, 128, WE + (long)E_WKN + (long)hh * 128 * 256, 9, e * 256, 0};
      t.s[n++] = Seg{10, (long)e * 256 * 2048 + hh * 256 + 128, 2048, 256, 128, WE + (long)E_WV + (long)hh * 128 * 256, 9, e * 256, 0};
    }
    t.s[n++] = Seg{12, (long)e * 2048 * 2048, 2048, 2048, 2048, WE + (long)E_WOUT, -1, 0, 0};
  }
  for (int o = 0; o < 2; ++o) {
    const long WO = (long)(2 * EVEN_SZ + o * ODD_SZ);
    const long so = (long)o * 2048 * 6144;
    t.s[n++] = Seg{13, so + 0, 6144, 2048, 4096, WO + (long)O_WUG, -1, 0, 0, 1};
    t.s[n++] = Seg{13, so + 2048, 6144, 2048, 2048, WO + (long)O_WV, -1, 0, 0};
    t.s[n++] = Seg{18, (long)o * 2048 * 2048, 2048, 2048, 2048, WO + (long)O_WOUT, -1, 0, 0};
  }
  int tiles = 0;
  for (int i = 0; i < n; ++i) { t.s[i].tile0 = tiles; tiles += (t.s[i].nrows / 64) * (t.s[i].K / 256); }
  t.n = n; t.ntiles = tiles;
  return t;
}
__constant__ SegTab c_segtab = make_segtab();
constexpr int NT_W = make_segtab().ntiles;
constexpr int N_MODITEMS = 4 * 96;
constexpr int N_ROPEITEMS = 128;
constexpr int N_PREP = NT_W + N_MODITEMS + N_ROPEITEMS;

namespace pg8 {
constexpr int BM = 256, BK = 64, HALF = 128, HTB = HALF * BK * 2, STAGE_BYTES = 8 * HTB, NXCD = 8, WGM = 8;
DI int lds_byte(int r, int c) { const int st = (r >> 4) * 2 + (c >> 5), rr = r & 15, cc = c & 31, ob = rr * 64 + cc * 2; return st * 1024 + (ob ^ (((ob >> 9) & 1) << 5)); }
DI void stage_rc(int b, int& R, int& C) { const int st = b / 1024, sb = b % 1024, swz = sb ^ (((sb >> 9) & 1) << 5); R = (st >> 1) * 16 + swz / 64; C = (st & 1) * 32 + (swz % 64) / 2; }
DI int perm32(int rho) { const int n = rho >> 4, i = rho & 15; return 8 * (i >> 2) + 4 * n + (i & 3); }
struct Unit { int pm, pn; };
struct Gemm { const bf16_t* A; const bf16_t* Bt; int M, N, K, lda, ldb; };
struct StaticOrder {
  int nM, nN, nwg, G, c;
  DI void init(int M, int N, int G_, int c_) { nM = M / BM; nN = N / BM; nwg = nM * nN; G = G_; c = c_; }
  DI bool next(int i, Unit& u) const {
    const long L = (long)i * G + c; if (L >= nwg) return false;
    int wgid = (int)L; { const int q = nwg / NXCD, r = nwg % NXCD, xcd = wgid % NXCD, off = wgid / NXCD; wgid = (xcd < r ? xcd * (q + 1) : r * (q + 1) + (xcd - r) * q) + off; }
    const int nig = WGM * nN, gid = wgid / nig, fm = gid * WGM, gsz = (nM - fm) < WGM ? (nM - fm) : WGM;
    u.pm = fm + ((wgid % nig) % gsz); u.pn = (wgid % nig) / gsz; return true;
  }
};
struct EpiBf16S {
  static constexpr bool PERM = true;
  bf16_t* O; int ldc; const float* rs; const float* cs; float* cst; int cst_ld; int ugmode;
  DI void operator()(const f32x4 (&acc)[2][2][4][2], const Unit& u, int wr, int wc, int fr, int fq) const {
    const int row0 = u.pm * BM + wr * 64 + fr, col0 = u.pn * BM + wc * 64 + 8 * fq;
    if (ugmode) {
      const int oc = u.pn * 128 + wc * 32 + 8 * fq;
#pragma unroll
      for (int ai = 0; ai < 2; ++ai)
#pragma unroll
        for (int m = 0; m < 4; ++m) {
          const int row = row0 + ai * HALF + m * 16;
          const f32x4 u0 = acc[ai][0][m][0], u1 = acc[ai][0][m][1], g0 = acc[ai][1][m][0], g1 = acc[ai][1][m][1];
          u32x4 o;
          o[0] = pk2(u0[0] * silu_f(g0[0]), u0[1] * silu_f(g0[1])); o[1] = pk2(u0[2] * silu_f(g0[2]), u0[3] * silu_f(g0[3]));
          o[2] = pk2(u1[0] * silu_f(g1[0]), u1[1] * silu_f(g1[1])); o[3] = pk2(u1[2] * silu_f(g1[2]), u1[3] * silu_f(g1[3]));
          *(u32x4*)(O + (size_t)row * ldc + oc) = o;
        }
      return;
    }
#pragma unroll
    for (int ai = 0; ai < 2; ++ai)
#pragma unroll
      for (int m = 0; m < 4; ++m) {
        const int row = row0 + ai * HALF + m * 16;
        float r = 1.0f;
        if (rs) r = rs[row];
        bf16_t* rowp = O + (size_t)row * ldc + col0;
#pragma unroll
        for (int bj = 0; bj < 2; ++bj) {
          f32x4 v0 = acc[ai][bj][m][0] * r, v1 = acc[ai][bj][m][1] * r;
          if (cs) { v0 *= *(const f32x4*)(cs + col0 + 32 * bj); v1 *= *(const f32x4*)(cs + col0 + 32 * bj + 4); }
          u32x4 o; o[0] = pk2(v0[0], v0[1]); o[1] = pk2(v0[2], v0[3]); o[2] = pk2(v1[0], v1[1]); o[3] = pk2(v1[2], v1[3]);
          *(u32x4*)(rowp + 32 * bj) = o;
        }
      }
    if (cst) {
#pragma unroll
      for (int bj = 0; bj < 2; ++bj) {
        f32x4 s0 = {0.f, 0.f, 0.f, 0.f}, s1 = s0, q0 = s0, q1 = s0;
#pragma unroll
        for (int ai = 0; ai < 2; ++ai)
#pragma unroll
          for (int m = 0; m < 4; ++m) {
            const f32x4 v0 = acc[ai][bj][m][0], v1 = acc[ai][bj][m][1];
            s0 += v0; s1 += v1; q0 += v0 * v0; q1 += v1 * v1;
          }
#pragma unroll
        for (int off = 1; off < 16; off <<= 1)
#pragma unroll
          for (int e = 0; e < 4; ++e) {
            s0[e] += __shfl_xor(s0[e], off); s1[e] += __shfl_xor(s1[e], off);
            q0[e] += __shfl_xor(q0[e], off); q1[e] += __shfl_xor(q1[e], off);
          }
        if (fr == 0) {
          float* bp = cst + (size_t)((u.pm * 2 + wr) * 2) * cst_ld + col0 + 32 * bj;
          *(f32x4*)bp = s0; *(f32x4*)(bp + 4) = s1;
          *(f32x4*)(bp + cst_ld) = q0; *(f32x4*)(bp + cst_ld + 4) = q1;
        }
      }
    }
  }
};

typedef EpiBf16S Epi;
DI void gemm_phase(LAS unsigned char* lds, const Gemm g, const StaticOrder& S, const Epi& E) {
  const int tid = get_tid(), wid = __builtin_amdgcn_readfirstlane(tid >> 6), lane = tid & 63, wr = wid >> 2, wc = wid & 3, fr = lane & 15, fq = lane >> 4;
  const int K = g.K, nt = K / BK;
  unsigned voffA[2], voffB0[2], voffB1[2];
#pragma unroll
  for (int i = 0; i < 2; ++i) { int R, C; stage_rc(tid * 16 + i * 8192, R, C);
    const int Rb = 64 * (R >> 5) + 8 * ((R & 15) >> 2) + 4 * ((R >> 4) & 1) + (R & 3);
    voffA[i] = (unsigned)(R * g.lda + C) * 2u; voffB0[i] = (unsigned)(Rb * g.ldb + C) * 2u; voffB1[i] = (unsigned)((Rb + 32) * g.ldb + C) * 2u; }
  const size_t kstep = (size_t)(BK * 2);
  const size_t hstepA = (size_t)HALF * g.lda * 2, hstepB = (size_t)HALF * g.ldb * 2;
  const size_t tstepA = 2 * hstepA, tstepB = 2 * hstepB;
  const unsigned ldsw = (unsigned)wid * 1024u;
  const int aoff = lds_byte(wr * 64 + fr, fq * 8), boff = lds_byte(wc * 32 + fr, fq * 8);
#define PG8_SA(b, h) (((b) * 2 + (h)) * HTB)
#define PG8_SB(b, h) ((4 + (b) * 2 + (h)) * HTB)
#define PG8_STAGE(bufoff, gbase, voff) do { _Pragma("unroll") for (int _i = 0; _i < 2; ++_i) \
    __builtin_amdgcn_global_load_lds((const unsigned*)((const char*)(gbase) + (voff)[_i]), (LAS unsigned*)(lds + (bufoff) + ldsw + _i * 8192), 16, 0, 0); } while (0)
#define PG8_LDA(dst, b, h) do { _Pragma("unroll") for (int m = 0; m < 4; ++m) _Pragma("unroll") for (int k = 0; k < 2; ++k) dst[m][k] = *(const LAS bf16x8*)(lds + PG8_SA(b, h) + aoff + m * 2048 + k * 1024); } while (0)
#define PG8_LDB(dst, b, h) do { _Pragma("unroll") for (int n = 0; n < 2; ++n) _Pragma("unroll") for (int k = 0; k < 2; ++k) dst[n][k] = *(const LAS bf16x8*)(lds + PG8_SB(b, h) + boff + n * 2048 + k * 1024); } while (0)
#define PG8_MMA(ai, bj, At, Bt) do { __builtin_amdgcn_s_setprio(1); _Pragma("unroll") for (int m = 0; m < 4; ++m) _Pragma("unroll") for (int n = 0; n < 2; ++n) _Pragma("unroll") for (int k = 0; k < 2; ++k) \
    acc[ai][bj][m][n] = __builtin_amdgcn_mfma_f32_16x16x32_bf16(Bt[n][k], At[m][k], acc[ai][bj][m][n], 0, 0, 0); __builtin_amdgcn_s_setprio(0); } while (0)
#define PG8_WAIT_V(n) asm volatile("s_waitcnt vmcnt(" #n ")" ::: "memory")
#define PG8_WAIT_L(n) asm volatile("s_waitcnt lgkmcnt(" #n ")" ::: "memory")
#define PG8_BAR __builtin_amdgcn_s_barrier()
#define PG8_SCHED __builtin_amdgcn_sched_barrier(0)
  Unit cur, nxt; int ui = 0;
  if (!S.next(0, cur)) return;
  f32x4 acc[2][2][4][2];
#pragma unroll
  for (int a = 0; a < 2; ++a)
#pragma unroll
    for (int b = 0; b < 2; ++b)
#pragma unroll
      for (int m = 0; m < 4; ++m)
#pragma unroll
        for (int n = 0; n < 2; ++n) acc[a][b][m][n] = (f32x4){0.f, 0.f, 0.f, 0.f};
  bf16x8 At[4][2], B0[2][2], B1[2][2];
  const char* cA = (const char*)g.A + (size_t)cur.pm * tstepA; const char* cB = (const char*)g.Bt + (size_t)cur.pn * tstepB;
  PG8_STAGE(PG8_SB(0, 0), cB, voffB0); PG8_STAGE(PG8_SA(0, 0), cA, voffA); PG8_STAGE(PG8_SB(0, 1), cB, voffB1); PG8_STAGE(PG8_SA(0, 1), cA + hstepA, voffA);
  if (wr == 1) PG8_BAR;
  PG8_WAIT_V(4); PG8_BAR;
  PG8_STAGE(PG8_SB(1, 0), cB + kstep, voffB0); PG8_STAGE(PG8_SA(1, 0), cA + kstep, voffA); PG8_STAGE(PG8_SB(1, 1), cB + kstep, voffB1);
  PG8_WAIT_V(6); PG8_BAR;
  for (;;) {
    const bool has_next = S.next(ui + 1, nxt);
    const char* nA = has_next ? (const char*)g.A + (size_t)nxt.pm * tstepA : cA; const char* nB = has_next ? (const char*)g.Bt + (size_t)nxt.pn * tstepB : cB;
    for (int t = 0; t < nt; t += 2) {
      const bool last = (t == nt - 2);
      const char* a1 = cA + (size_t)(t + 1) * kstep;
      const char* a2 = last ? nA : cA + (size_t)(t + 2) * kstep; const char* b2 = last ? nB : cB + (size_t)(t + 2) * kstep;
      const char* a3 = a2 + kstep; const char* b3 = b2 + kstep;
      PG8_LDB(B0, 0, 0); PG8_SCHED; PG8_LDA(At, 0, 0); PG8_STAGE(PG8_SA(1, 1), a1 + hstepA, voffA);
      PG8_WAIT_L(8); PG8_BAR; PG8_WAIT_L(0); PG8_MMA(0, 0, At, B0); PG8_BAR; PG8_SCHED;
      PG8_LDB(B1, 0, 1); PG8_STAGE(PG8_SB(0, 0), b2, voffB0);
      PG8_BAR; PG8_WAIT_L(0); PG8_MMA(0, 1, At, B1); PG8_BAR;
      PG8_LDA(At, 0, 1); PG8_STAGE(PG8_SA(0, 0), a2, voffA);
      PG8_BAR; PG8_WAIT_L(0); PG8_MMA(1, 0, At, B0); PG8_BAR; PG8_SCHED;
      PG8_STAGE(PG8_SB(0, 1), b2, voffB1);
      PG8_WAIT_V(6); PG8_BAR; PG8_MMA(1, 1, At, B1); PG8_BAR;
      PG8_LDB(B0, 1, 0); PG8_SCHED; PG8_LDA(At, 1, 0); PG8_STAGE(PG8_SA(0, 1), a2 + hstepA, voffA);
      PG8_WAIT_L(8); PG8_BAR; PG8_WAIT_L(0); PG8_MMA(0, 0, At, B0); PG8_BAR; PG8_SCHED;
      PG8_LDB(B1, 1, 1); PG8_STAGE(PG8_SB(1, 0), b3, voffB0);
      PG8_BAR; PG8_WAIT_L(0); PG8_MMA(0, 1, At, B1); PG8_BAR;
      PG8_LDA(At, 1, 1); PG8_STAGE(PG8_SA(1, 0), a3, voffA);
      PG8_BAR; PG8_WAIT_L(0); PG8_MMA(1, 0, At, B0); PG8_BAR; PG8_SCHED;
      PG8_STAGE(PG8_SB(1, 1), b3, voffB1);
      PG8_WAIT_V(6); PG8_BAR; PG8_MMA(1, 1, At, B1); PG8_BAR;
    }
    E(acc, cur, wr, wc, fr, fq);
    if (!has_next) break;
#pragma unroll
    for (int a = 0; a < 2; ++a)
#pragma unroll
      for (int b = 0; b < 2; ++b)
#pragma unroll
        for (int m = 0; m < 4; ++m)
#pragma unroll
          for (int n = 0; n < 2; ++n) acc[a][b][m][n] = (f32x4){0.f, 0.f, 0.f, 0.f};
    cur = nxt; cA = nA; cB = nB; ++ui;
  }
  PG8_WAIT_V(0);
  if (wr == 0) PG8_BAR;
  PG8_BAR;
#undef PG8_SA
#undef PG8_SB
#undef PG8_STAGE
#undef PG8_LDA
#undef PG8_LDB
#undef PG8_MMA
#undef PG8_WAIT_V
#undef PG8_WAIT_L
#undef PG8_BAR
#undef PG8_SCHED
}
}

struct GemmDesc { const bf16_t* A; const bf16_t* Bt; bf16_t* O; const float* rs; const float* cs; float* cst; int lda, ldb, M, N, K, ldc, ugmode; };

__device__ void prep_transpose_tile(KP p, int tile, unsigned char* smem) {
  int si = 0;
  const int nseg = c_segtab.n;
  for (int i = 1; i < nseg; ++i) if (c_segtab.s[i].tile0 <= tile) si = i;
  const Seg sg = c_segtab.s[si];
  const int lt = tile - sg.tile0, nkt = sg.K / 256, nt_ = lt / nkt, kt_ = lt % nkt;
  const int n0 = nt_ * 64, k0 = kt_ * 256, tid = get_tid();
  constexpr int RS = 129;
  unsigned* L = (unsigned*)smem;
  bf16_t* dst = (bf16_t*)(p->ws + B_W) + sg.dst_off;
  if (sg.in_idx >= 0) {
    const float* src = p->in[sg.in_idx] + sg.src_off;
    const int kk2 = tid >> 4, nq = tid & 15;
    f32x4 r0[4], r1[4];
    const int scol = sg.split ? ((n0 >> 6) * 32 + ((4 * nq) & 31) + ((4 * nq) >> 5) * 4096) : (n0 + 4 * nq);
#pragma unroll
    for (int sub = 0; sub < 4; ++sub) {
      const int k = k0 + 64 * sub + 2 * kk2;
      r0[sub] = *(const f32x4*)(src + (size_t)k * sg.ld + scol);
      r1[sub] = *(const f32x4*)(src + (size_t)(k + 1) * sg.ld + scol);
    }
    if (sg.sc_idx >= 0) {
      const float* sc = p->in[sg.sc_idx] + sg.sc_off;
#pragma unroll
      for (int sub = 0; sub < 4; ++sub) { const int k = k0 + 64 * sub + 2 * kk2; r0[sub] *= sc[k]; r1[sub] *= sc[k + 1]; }
    }
#pragma unroll
    for (int sub = 0; sub < 4; ++sub)
#pragma unroll
      for (int e = 0; e < 4; ++e) L[(4 * nq + e) * RS + sub * 32 + kk2] = pk2(r0[sub][e], r1[sub][e]);
  } else {
    for (int i = tid; i < 64 * RS; i += 512) L[i] = 0u;
  }
  __syncthreads();
  {
    const int n = tid >> 3, kq = tid & 7;
#pragma unroll
    for (int j = 0; j < 4; ++j) {
      const int c = kq + 8 * j;
      u32x4 o; o[0] = L[n * RS + 4 * c]; o[1] = L[n * RS + 4 * c + 1]; o[2] = L[n * RS + 4 * c + 2]; o[3] = L[n * RS + 4 * c + 3];
      *(u32x4*)(dst + (size_t)(n0 + n) * sg.K + k0 + 8 * c) = o;
    }
  }
  __syncthreads();
}

__device__ void prep_mod_item(KP p, int item, unsigned char* smem) {
  const int l = item / 96, cc = item % 96, tid = get_tid();
  float* csL = (float*)smem;
  float* red = (float*)(smem + 65536);
  const float* c = p->in[1];
  for (int i = tid; i < 8 * 2048; i += 512) csL[i] = silu_f(c[i]);
  __syncthreads();
  const int cq = tid & 15, kg = tid >> 4;
  const float* w = p->in[2] + ((size_t)l * 2048 + (size_t)kg * 64) * 6144 + cc * 64 + 4 * cq;
  f32x4 acc[8];
#pragma unroll
  for (int b = 0; b < 8; ++b) acc[b] = (f32x4){0.f, 0.f, 0.f, 0.f};
#pragma unroll 8
  for (int kk = 0; kk < 64; ++kk) {
    const f32x4 wv = *(const f32x4*)(w + (size_t)kk * 6144);
    const int k = kg * 64 + kk;
#pragma unroll
    for (int b = 0; b < 8; ++b) acc[b] += wv * csL[b * 2048 + k];
  }
#pragma unroll
  for (int b = 0; b < 8; ++b) *(f32x4*)(red + ((kg * 8 + b) * 64 + 4 * cq)) = acc[b];
  __syncthreads();
  {
    const int b = tid >> 6, col = tid & 63;
    float s = 0.f;
    for (int k2 = 0; k2 < 32; ++k2) s += red[(k2 * 8 + b) * 64 + col];
    float* mod = (float*)(p->ws + B_MOD);
    mod[((size_t)l * 8 + b) * 6144 + cc * 64 + col] = s + p->in[3][(size_t)l * 6144 + cc * 64 + col];
  }
  __syncthreads();
}

__device__ void prep_phase(KP p, unsigned char* smem) {
  const int tid0 = get_tid();
  for (int it = blockIdx.x; it < N_PREP; it += gridDim.x) {
    if (it < N_MODITEMS) prep_mod_item(p, it, smem);
    else if (it < N_MODITEMS + NT_W) prep_transpose_tile(p, it - N_MODITEMS, smem);
    else {
      const int idx = (it - N_MODITEMS - NT_W) * 512 + tid0;
      const int pos = idx >> 5, i = idx & 31;
      const float freq = powf(10000.0f, -(float)i / 32.0f);
      const float ang = (float)pos * freq;
      ((float*)(p->ws + B_COS))[idx] = cosf(ang);
      ((float*)(p->ws + B_SIN))[idx] = sinf(ang);
    }
  }
}

__device__ void rows_phase(KP p, int l_done, int l_next) {
  const int tid = get_tid(), w = __builtin_amdgcn_readfirstlane(tid >> 6), lane = tid & 63;
  const float* mod = (const float*)(p->ws + B_MOD);
  const bf16_t* yo = (const bf16_t*)(p->ws + B_Z);
  bf16_t* hb = (bf16_t*)(p->ws + B_H);
  bf16_t* xb = (bf16_t*)(p->ws + B_XB);
  const float* xin = p->in[0];
  float* xout = p->out;
  const bool in_bf = l_done >= 1, out_f32 = l_done == 3;
  for (int base = blockIdx.x * 64; base < T; base += gridDim.x * 64) {
    const int row0 = base + w * 8, b = row0 >> 11;
    f32x4 gg[8], pa[8], pb[8];
    if (l_done >= 0) {
      const float* gp = p->in[5] + (size_t)l_done * DM;
      const float* gt = mod + ((size_t)l_done * 8 + b) * 6144 + 4096;
#pragma unroll
      for (int i = 0; i < 8; ++i) { const int c = 8 * (lane + 64 * (i >> 1)) + 4 * (i & 1); gg[i] = *(const f32x4*)(gp + c) * *(const f32x4*)(gt + c); }
    }
    if (l_next < 4) {
      const float* gp = p->in[4] + (size_t)l_next * DM;
      const float* sh = mod + ((size_t)l_next * 8 + b) * 6144;
#pragma unroll
      for (int i = 0; i < 8; ++i) { const int c = 8 * (lane + 64 * (i >> 1)) + 4 * (i & 1); pa[i] = *(const f32x4*)(gp + c) * (*(const f32x4*)(sh + 2048 + c) + 1.0f); pb[i] = *(const f32x4*)(sh + c); }
    }
    f32x4 xn[8]; u32x4 yn[4];
#pragma unroll
    for (int i = 0; i < 4; ++i) {
      const size_t o = (size_t)row0 * DM + 8 * (lane + 64 * i);
      if (in_bf) xn[i] = *(const f32x4*)(xb + o);
      else { xn[2 * i] = *(const f32x4*)(xin + o); xn[2 * i + 1] = *(const f32x4*)(xin + o + 4); }
      if (l_done >= 0) yn[i] = *(const u32x4*)(yo + o);
    }
#pragma unroll 1
    for (int k = 0; k < 8; ++k) {
      const int row = row0 + k;
      f32x4 xv[8]; u32x4 yr[4];
      if (in_bf) {
#pragma unroll
        for (int i = 0; i < 4; ++i) {
          const u32x4 r = __builtin_bit_cast(u32x4, xn[i]);
          xv[2 * i] = (f32x4){bflo(r[0]), bfhi(r[0]), bflo(r[1]), bfhi(r[1])};
          xv[2 * i + 1] = (f32x4){bflo(r[2]), bfhi(r[2]), bflo(r[3]), bfhi(r[3])};
        }
      } else {
#pragma unroll
        for (int i = 0; i < 8; ++i) xv[i] = xn[i];
      }
#pragma unroll
      for (int i = 0; i < 4; ++i) yr[i] = yn[i];
      if (k < 7) {
#pragma unroll
        for (int i = 0; i < 4; ++i) {
          const size_t o = (size_t)(row + 1) * DM + 8 * (lane + 64 * i);
          if (in_bf) xn[i] = *(const f32x4*)(xb + o);
          else { xn[2 * i] = *(const f32x4*)(xin + o); xn[2 * i + 1] = *(const f32x4*)(xin + o + 4); }
          if (l_done >= 0) yn[i] = *(const u32x4*)(yo + o);
        }
      }
      if (l_done >= 0) {
        float ss = 0.f;
#pragma unroll
        for (int i = 0; i < 4; ++i)
#pragma unroll
          for (int j = 0; j < 4; ++j) { const float lo = bflo(yr[i][j]), hi = bfhi(yr[i][j]); ss += lo * lo + hi * hi; }
        ss = wave_sum(ss);
        const float rinv = rsqrtf(ss * (1.0f / DM) + EPS);
#pragma unroll
        for (int i = 0; i < 4; ++i) {
          const f32x4 y0 = {bflo(yr[i][0]), bfhi(yr[i][0]), bflo(yr[i][1]), bfhi(yr[i][1])}, y1 = {bflo(yr[i][2]), bfhi(yr[i][2]), bflo(yr[i][3]), bfhi(yr[i][3])};
          xv[2 * i] += gg[2 * i] * (y0 * rinv); xv[2 * i + 1] += gg[2 * i + 1] * (y1 * rinv);
        }
        if (out_f32) {
#pragma unroll
          for (int i = 0; i < 8; ++i) __builtin_nontemporal_store(xv[i], (f32x4*)(xout + (size_t)row * DM + 8 * (lane + 64 * (i >> 1)) + 4 * (i & 1)));
        } else {
#pragma unroll
          for (int i = 0; i < 4; ++i) {
            u32x4 o; o[0] = pk2(xv[2 * i][0], xv[2 * i][1]); o[1] = pk2(xv[2 * i][2], xv[2 * i][3]); o[2] = pk2(xv[2 * i + 1][0], xv[2 * i + 1][1]); o[3] = pk2(xv[2 * i + 1][2], xv[2 * i + 1][3]);
            *(u32x4*)(xb + (size_t)row * DM + 8 * (lane + 64 * i)) = o;
          }
        }
      }
      if (l_next < 4) {
        float ss = 0.f;
#pragma unroll
        for (int i = 0; i < 8; ++i) ss += xv[i][0] * xv[i][0] + xv[i][1] * xv[i][1] + xv[i][2] * xv[i][2] + xv[i][3] * xv[i][3];
        ss = wave_sum(ss);
        const float rinv = rsqrtf(ss * (1.0f / DM) + EPS);
#pragma unroll
        for (int i = 0; i < 4; ++i) {
          const int c = 8 * (lane + 64 * i);
          u32x4 o;
#pragma unroll
          for (int hlf = 0; hlf < 2; ++hlf) {
            const f32x4 hv = (xv[2 * i + hlf] * rinv) * pa[2 * i + hlf] + pb[2 * i + hlf];
            o[2 * hlf] = pk2(hv[0], hv[1]); o[2 * hlf + 1] = pk2(hv[2], hv[3]);
          }
          *(u32x4*)(hb + (size_t)row * DM + c) = o;
        }
      }
    }
  }
}

__device__ void even_stats_phase(KP p) {
  const int tid = get_tid(), w = tid >> 6, lane = tid & 63;
  const bf16_t* z1 = (const bf16_t*)(p->ws + B_Z);
  float* rsq = (float*)(p->ws + B_ST0); float* rskv = (float*)(p->ws + B_ST1);
  bf16_t* kr = (bf16_t*)(p->ws + B_KR);
  const float* cosT = (const float*)(p->ws + B_COS); const float* sinT = (const float*)(p->ws + B_SIN);
  for (int base = blockIdx.x * 64; base < T; base += gridDim.x * 64) {
    const int t0 = base + w * 8;
    u32x4 a[8]; u32x2 c[8]; unsigned short kq[8]; float cs[8], sn[8];
#pragma unroll
    for (int k = 0; k < 8; ++k) {
      const bf16_t* zr = z1 + (size_t)(t0 + k) * 5120;
      a[k] = *(const u32x4*)(zr + 8 * lane);
      c[k] = *(const u32x2*)(zr + 512 + 4 * lane);
      kq[k] = zr[768 + lane];
      const int pos = (t0 + k) & (SEQ - 1);
      cs[k] = cosT[pos * 32 + (lane & 31)]; sn[k] = sinT[pos * 32 + (lane & 31)];
    }
#pragma unroll
    for (int k = 0; k < 8; ++k) {
      const int t = t0 + k;
      const float kv = bf1(kq[k]);
      float s1 = 0.f, s2 = 0.f;
#pragma unroll
      for (int i = 0; i < 4; ++i) { const float lo = bflo(a[k][i]), hi = bfhi(a[k][i]); s1 += lo * lo + hi * hi; }
#pragma unroll
      for (int i = 0; i < 2; ++i) { const float lo = bflo(c[k][i]), hi = bfhi(c[k][i]); s2 += lo * lo + hi * hi; }
      s1 = wave_sum(s1); s2 = wave_sum(s2);
      const float other = __shfl_xor(kv, 32);
      const float res = (lane < 32) ? (kv * cs[k] - other * sn[k]) : (other * sn[k] + kv * cs[k]);
      const unsigned pk = pk2(res, 0.f);
      kr[(size_t)t * 64 + lane] = (bf16_t)(pk & 0xffffu);
      if (lane == 0) {
        rsq[t] = rsqrtf(s1 * (1.0f / 512.0f) + EPS) * (0.07216878364870323f * LOG2E);
        rskv[t] = rsqrtf(s2 * (1.0f / 256.0f) + EPS);
      }
    }
  }
}

#define MFMA32(a, b, c) __builtin_amdgcn_mfma_f32_32x32x16_bf16((a), (b), (c), 0, 0, 0)
template <int DK, bool BAND, int MODE>
__device__ void attn_item(KP p, int e, int b, int h, int qb, unsigned char* smem) {
  constexpr int KSTR = (DK + 8) * 2, VSTR = 144, KBYTES = 64 * KSTR, VBYTES = 128 * VSTR, STAGE = KBYTES + VBYTES;
  constexpr int NKK = DK / 16, PPK = DK / 8, KP = (64 * PPK) / 512;
  const int tid = get_tid(), w = tid >> 6, lane = tid & 63, r = lane & 31, g = lane >> 5;
  const int myc = 4 * qb + (w >> 1);
  const int kt_lo = BAND ? (4 * qb - 8 > 0 ? 4 * qb - 8 : 0) : 0, kt_hi = 4 * qb + 3;
  const size_t tok0 = (size_t)b * SEQ;
  const int qpos = qb * 256 + 32 * w + r;
  const size_t qtok = tok0 + qpos;
  const bf16_t* z1 = (const bf16_t*)(p->ws + B_Z);
  const bf16_t* qA = (const bf16_t*)(p->ws + B_Q);
  const bf16_t* knA = (const bf16_t*)(p->ws + B_KN);
  const bf16_t* krr = (const bf16_t*)(p->ws + B_KR);
  const bf16_t* Vt = (const bf16_t*)(p->ws + B_VT) + (BAND ? (size_t)0 : (size_t)1024 * T) + (size_t)h * 128 * T;
  bf16_t* yb = (bf16_t*)(p->ws + (MODE ? B_H : B_Y));
  float* biasS = (float*)(smem + 2 * STAGE);

  __syncthreads();
  if (BAND) { if (tid < 257) biasS[tid] = p->in[11][((size_t)e * 8 + h) * 257 + tid] * LOG2E; }
  u32x4 kreg[KP], vreg[2];
  unsigned koff[KP], klds[KP], voff[2], vlds[2];
#pragma unroll
  for (int i = 0; i < KP; ++i) {
    int key, pc;
    if (!BAND && i == 2) { key = tid >> 3; pc = 16 + (tid & 7); koff[i] = (unsigned)(key * 64 + (tid & 7) * 8) * 2u; }
    else { const int pidx = tid + 512 * i; key = pidx >> 4; pc = pidx & 15; koff[i] = (unsigned)(key * (BAND ? 5120 : 1024) + pc * 8) * 2u; }
    const int rho = (key & ~12) | ((key & 4) << 1) | ((key & 8) >> 1);
    klds[i] = (unsigned)(rho * KSTR + pc * 16);
  }
#pragma unroll
  for (int i = 0; i < 2; ++i) {
    const int pidx = tid + 512 * i, d = pidx >> 3, pc = pidx & 7;
    voff[i] = (unsigned)(d * T + pc * 8) * 2u; vlds[i] = (unsigned)(KBYTES + d * VSTR + pc * 16);
  }
  const char* kb0 = BAND ? (const char*)(z1 + tok0 * 5120 + 2048 + h * 128) : (const char*)(knA + tok0 * 1024 + h * 128);
  const char* kb1 = (const char*)(krr + tok0 * 64);
  const char* vb0 = (const char*)(Vt + tok0);
  auto load_tile = [&](int kt) {
    const char* kb = kb0 + (size_t)kt * 64 * (BAND ? 5120 : 1024) * 2;
    const char* kr2 = kb1 + (size_t)kt * 64 * 64 * 2;
    const char* vb = vb0 + (size_t)kt * 64 * 2;
#pragma unroll
    for (int i = 0; i < KP; ++i) {
      if (!BAND && i == 2) kreg[i] = *(const u32x4*)(kr2 + koff[i]);
      else kreg[i] = *(const u32x4*)(kb + koff[i]);
    }
#pragma unroll
    for (int i = 0; i < 2; ++i) vreg[i] = *(const u32x4*)(vb + voff[i]);
  };
  auto store_tile = [&](int st) {
    unsigned char* Ks = smem + st * STAGE;
#pragma unroll
    for (int i = 0; i < KP; ++i) *(u32x4*)(Ks + klds[i]) = kreg[i];
#pragma unroll
    for (int i = 0; i < 2; ++i) *(u32x4*)(Ks + vlds[i]) = vreg[i];
  };

  load_tile(kt_lo);

  bf16x8 Qf[8];
  unsigned char* qs = smem + 2 * STAGE + w * 4096;
  if (!BAND) {
    const bf16_t* qp = qA + qtok * 1536 + h * 192 + 8 * g;
#pragma unroll
    for (int kk = 0; kk < 8; ++kk) Qf[kk] = *(const bf16x8*)(qp + 16 * kk);
    const float* cp = (const float*)(p->ws + B_COS) + qpos * 32 + 8 * g;
    const float* sp = (const float*)(p->ws + B_SIN) + qpos * 32 + 8 * g;
#pragma unroll
    for (int hf = 0; hf < 2; ++hf) {
      bf16x8 x1v = *(const bf16x8*)(qp + 16 * (8 + hf)), x2v = *(const bf16x8*)(qp + 16 * (10 + hf));
#pragma unroll
      for (int j = 0; j < 8; j += 2) {
        const float c0 = cp[16 * hf + j], s0 = sp[16 * hf + j], c1 = cp[16 * hf + j + 1], s1 = sp[16 * hf + j + 1];
        const float a0 = bf1((unsigned short)x1v[j]), b0 = bf1((unsigned short)x2v[j]), a1 = bf1((unsigned short)x1v[j + 1]), b1 = bf1((unsigned short)x2v[j + 1]);
        const unsigned o1 = pk2(a0 * c0 - b0 * s0, a1 * c1 - b1 * s1), o2 = pk2(a0 * s0 + b0 * c0, a1 * s1 + b1 * c1);
        x1v[j] = (short)(o1 & 0xffffu); x1v[j + 1] = (short)(o1 >> 16);
        x2v[j] = (short)(o2 & 0xffffu); x2v[j + 1] = (short)(o2 >> 16);
      }
      *(bf16x8*)(qs + hf * 1024 + lane * 16) = x1v; *(bf16x8*)(qs + (2 + hf) * 1024 + lane * 16) = x2v;
    }
  } else {
    const bf16_t* qp = z1 + qtok * 5120 + 1024 + h * 128 + 8 * g;
    const float qs = 0.08838834764831845f * LOG2E;
#pragma unroll
    for (int kk = 0; kk < NKK; ++kk) {
      bf16x8 v = *(const bf16x8*)(qp + 16 * kk);
#pragma unroll
      for (int j = 0; j < 8; j += 2) {
        const unsigned o = pk2(bf1((unsigned short)v[j]) * qs, bf1((unsigned short)v[j + 1]) * qs);
        v[j] = (short)(o & 0xffffu); v[j + 1] = (short)(o >> 16);
      }
      Qf[kk] = v;
    }
  }

  f32x16 O[4];
#pragma unroll
  for (int dt = 0; dt < 4; ++dt)
#pragma unroll
    for (int i = 0; i < 16; ++i) O[dt][i] = 0.f;
  float mrun = 0.f, lsum = 0.f;
  bool fresh = true;

  store_tile(0);
  __syncthreads();
  for (int kt = kt_lo; kt <= kt_hi; ++kt) {
    const int cur = (kt - kt_lo) & 1;
    if (MODE != 2 && kt < kt_hi) load_tile(kt + 1);
    const bool active = (MODE != 1) && (BAND ? (kt <= myc && kt >= myc - 8) : (kt <= myc));
    if (active) {
      const unsigned char* Ks = smem + cur * STAGE;
      const unsigned char* Vs = Ks + KBYTES;
      f32x16 S0, S1;
      {
        const float negm = -mrun;
#pragma unroll
        for (int i = 0; i < 16; ++i) { S0[i] = negm; S1[i] = negm; }
      }
      {
        bf16x8 kf[2][NKK], qr[4];
        const unsigned char* kp = Ks + r * KSTR + 16 * g;
        if (!BAND) {
#pragma unroll
          for (int j = 0; j < 4; ++j) qr[j] = *(const bf16x8*)(qs + j * 1024 + lane * 16);
        }
#pragma unroll
        for (int sub = 0; sub < 2; ++sub)
#pragma unroll
          for (int kk = 0; kk < NKK; ++kk) kf[sub][kk] = *(const bf16x8*)(kp + 32 * sub * KSTR + 32 * kk);
#pragma unroll
        for (int kk = 0; kk < NKK; ++kk) S0 = MFMA32(kf[0][kk], (kk < 8) ? Qf[kk < 8 ? kk : 0] : qr[kk >= 8 ? kk - 8 : 0], S0);
#pragma unroll
        for (int kk = 0; kk < NKK; ++kk) S1 = MFMA32(kf[1][kk], (kk < 8) ? Qf[kk < 8 ? kk : 0] : qr[kk >= 8 ? kk - 8 : 0], S1);
        constexpr int NRD = 2 * NKK + (BAND ? 0 : 4), NMM = 2 * NKK, PRE = BAND ? 5 : 9;
        __builtin_amdgcn_sched_group_barrier(0x100, PRE, 0);
#pragma unroll
        for (int i = 0; i < NRD - PRE; ++i) { __builtin_amdgcn_sched_group_barrier(0x008, 1, 0); __builtin_amdgcn_sched_group_barrier(0x100, 1, 0); }
        __builtin_amdgcn_sched_group_barrier(0x008, NMM - (NRD - PRE), 0);
      }
      if (BAND) {
        if (kt >= myc - 2) {
          const int rel0 = qpos - (kt * 64 + 8 * g);
#pragma unroll
          for (int i = 0; i < 16; ++i) {
            const int rel = rel0 - (16 * (i >> 3) + (i & 7));
            const int i0 = rel < 128 ? rel : 128, i1 = (rel - 32) < 128 ? (rel - 32) : 128;
            S0[i] += biasS[i0 + 128]; S1[i] += biasS[i1 + 128];
          }
        } else {
          const float cb = biasS[256];
#pragma unroll
          for (int i = 0; i < 16; ++i) { S0[i] += cb; S1[i] += cb; }
        }
      }
      float mx = __builtin_fmaxf(S0[0], S1[0]);
#pragma unroll
      for (int i = 1; i < 16; ++i) mx = max3f(mx, S0[i], S1[i]);
      mx = fmaxf(mx, __shfl_xor(mx, 32));
      if (__any(mx > 8.0f) || fresh) {
        const float d = fresh ? mx : fmaxf(mx, 0.f);
        const float alpha = fresh ? 1.0f : __builtin_amdgcn_exp2f(-d);
        mrun += d;
        lsum *= alpha;
#pragma unroll
        for (int dt = 0; dt < 4; ++dt)
#pragma unroll
          for (int i = 0; i < 16; ++i) O[dt][i] *= alpha;
#pragma unroll
        for (int i = 0; i < 16; ++i) { S0[i] -= d; S1[i] -= d; }
        fresh = false;
      }
      {
        bf16x8 vf[2][2][4];
        const unsigned char* vp = Vs + r * VSTR + 16 * g;
#pragma unroll
        for (int sub = 0; sub < 2; ++sub)
#pragma unroll
          for (int kb = 0; kb < 2; ++kb)
#pragma unroll
            for (int dt = 0; dt < 4; ++dt) vf[sub][kb][dt] = *(const bf16x8*)(vp + 32 * dt * VSTR + 64 * sub + 32 * kb);
        float ps = 0.f;
#pragma unroll
        for (int sub = 0; sub < 2; ++sub) {
#pragma unroll
          for (int i = 0; i < 16; ++i) {
            if (sub == 0) { S0[i] = __builtin_amdgcn_exp2f(S0[i]); ps += S0[i]; }
            else { S1[i] = __builtin_amdgcn_exp2f(S1[i]); ps += S1[i]; }
          }
#pragma unroll
          for (int kb = 0; kb < 2; ++kb) {
            u32x4 pp;
#pragma unroll
            for (int j = 0; j < 4; ++j) pp[j] = sub ? pk2(S1[8 * kb + 2 * j], S1[8 * kb + 2 * j + 1]) : pk2(S0[8 * kb + 2 * j], S0[8 * kb + 2 * j + 1]);
            const bf16x8 Pf = __builtin_bit_cast(bf16x8, pp);
#pragma unroll
            for (int dt = 0; dt < 4; ++dt) O[dt] = MFMA32(vf[sub][kb][dt], Pf, O[dt]);
          }
        }
        lsum += ps;
        __builtin_amdgcn_sched_group_barrier(0x100, 8, 0);
        __builtin_amdgcn_sched_group_barrier(0x002, 40, 0);
#pragma unroll
        for (int i = 0; i < 8; ++i) { __builtin_amdgcn_sched_group_barrier(0x008, 1, 0); __builtin_amdgcn_sched_group_barrier(0x100, 1, 0); __builtin_amdgcn_sched_group_barrier(0x002, 5, 0); }
        __builtin_amdgcn_sched_group_barrier(0x008, 8, 0);
      }
    }
    if (MODE != 2 && kt < kt_hi) store_tile(cur ^ 1);
    __syncthreads();
  }
  lsum += __shfl_xor(lsum, 32);
  const float inv = 1.0f / lsum;
  const int ocol = (BAND ? 1024 : 0) + h * 128;
  const size_t rowbase = tok0 + qb * 256 + 32 * w;
  float* stg = (float*)(smem + w * 8704);
  u32x2 gts[16];
#pragma unroll
  for (int ps2 = 0; ps2 < 2; ++ps2)
#pragma unroll
    for (int j = 0; j < 8; ++j) {
      const int idx = lane + 64 * j, row = idx >> 4, piece = idx & 15;
      gts[ps2 * 8 + j] = *(const u32x2*)(z1 + (rowbase + row) * 5120 + 3072 + ocol + 64 * ps2 + 4 * piece);
    }
#pragma unroll
  for (int ps2 = 0; ps2 < 2; ++ps2) {
#pragma unroll
    for (int dd = 0; dd < 2; ++dd)
#pragma unroll
      for (int i4 = 0; i4 < 4; ++i4) {
        const int dt = 2 * ps2 + dd;
        f32x4 v; v[0] = O[dt][4 * i4] * inv; v[1] = O[dt][4 * i4 + 1] * inv; v[2] = O[dt][4 * i4 + 2] * inv; v[3] = O[dt][4 * i4 + 3] * inv;
        *(f32x4*)(stg + r * 68 + 32 * dd + 8 * i4 + 4 * g) = v;
      }
#pragma unroll
    for (int j = 0; j < 8; ++j) {
      const int idx = lane + 64 * j, row = idx >> 4, piece = idx & 15;
      const f32x4 v = *(const f32x4*)(stg + row * 68 + 4 * piece);
      const u32x2 gt = gts[ps2 * 8 + j];
      u32x2 o;
      o[0] = pk2(v[0] * silu_f(bflo(gt[0])), v[1] * silu_f(bfhi(gt[0])));
      o[1] = pk2(v[2] * silu_f(bflo(gt[1])), v[3] * silu_f(bfhi(gt[1])));
      *(u32x2*)(yb + (rowbase + row) * 2048 + ocol + 64 * ps2 + 4 * piece) = o;
    }
  }
}

template <int MODE>
__device__ void attn_phase(KP p, int e_ctr, unsigned char* smem) {
  const int e = e_ctr & 1;
  unsigned* ctr = (unsigned*)(p->ws + B_CTR) + e_ctr;
  int* slot = (int*)(smem + 131072 - 16);
  for (;;) {
    __syncthreads();
    if (get_tid() == 0) *slot = (int)atomicAdd(ctr, 1u);
    __syncthreads();
    const int item = *slot;
    if (item >= 1024) break;
    const int grp = item >> 6, bh = item & 63, b = bh >> 3, h = bh & 7;
    int ty, qb;
    if (grp < 6) { ty = 0; qb = 7 - grp; }
    else if (grp < 12) { ty = 1; qb = 13 - grp; }
    else { ty = grp & 1; qb = (grp < 14) ? 1 : 0; }
    if (ty == 0) attn_item<192, false, MODE>(p, e, b, h, qb, smem);
    else attn_item<128, true, MODE>(p, e, b, h, qb, smem);
  }
}

__device__ void gating_phase(KP p, int o, unsigned char* smem) {
  const bf16_t* vT = (const bf16_t*)(p->ws + B_VT);
  const bf16_t* ug = (const bf16_t*)(p->ws + B_Z);
  bf16_t* yb = (bf16_t*)(p->ws + B_Y);
  const float* cst = (const float*)(p->ws + B_KR);
  unsigned char* wsS = smem;
  float* muS = (float*)(smem + 34816); float* rsS = muS + 128; float* c1S = rsS + 128; float* c2S = c1S + 128;
  const int tid = get_tid(), w = tid >> 6, lane = tid & 63, fr = lane & 15, fq = lane >> 4;
  for (int item = blockIdx.x; item < 1024; item += gridDim.x) {
    const int g = item & 7, bn = item >> 3; const size_t tok0 = (size_t)bn * 128;
    __syncthreads();
    if (tid < 128) {
      float sm = 0.f, sq = 0.f;
#pragma unroll
      for (int k = 0; k < 16; ++k) { sm += cst[(size_t)(2 * k) * T + tok0 + tid]; sq += cst[(size_t)(2 * k + 1) * T + tok0 + tid]; }
      const float m = sm * (1.0f / 2048.0f);
      const float var = sq * (1.0f / 2048.0f) - m * m;
      muS[tid] = m; rsS[tid] = rsqrtf(fmaxf(var, 0.f) + EPS);
    }
    __syncthreads();
    {
      const int i = tid >> 2, jq = tid & 3;
      const float* wrow = p->in[16] + (((size_t)o * 8 + g) * 128 + i) * 128 + 32 * jq;
      float c1 = 0.f, c2 = 0.f;
#pragma unroll
      for (int q4 = 0; q4 < 8; q4 += 2) {
        const f32x4 wa = *(const f32x4*)(wrow + 4 * q4), wb = *(const f32x4*)(wrow + 4 * q4 + 4);
        float v[8];
#pragma unroll
        for (int e2 = 0; e2 < 8; ++e2) {
          const int j = 32 * jq + 4 * q4 + e2;
          const float wm = ((j >> 6) <= (i >> 6)) ? (e2 < 4 ? wa[e2 & 3] : wb[e2 & 3]) : 0.f;
          c2 += wm; const float wsv = wm * rsS[j]; c1 += wsv * muS[j]; v[e2] = wsv;
        }
        u32x4 o4; o4[0] = pk2(v[0], v[1]); o4[1] = pk2(v[2], v[3]); o4[2] = pk2(v[4], v[5]); o4[3] = pk2(v[6], v[7]);
        *(u32x4*)(wsS + i * 272 + (32 * jq + 4 * q4) * 2) = o4;
      }
      c1 += __shfl_xor(c1, 1); c1 += __shfl_xor(c1, 2);
      c2 += __shfl_xor(c2, 1); c2 += __shfl_xor(c2, 2);
      if (jq == 0) { c1S[i] = c1; c2S[i] = c2; }
    }
    const int d0 = g * 256 + 32 * w;
    bf16x8 Af[2][4];
#pragma unroll
    for (int dt = 0; dt < 2; ++dt)
#pragma unroll
      for (int ks = 0; ks < 4; ++ks) Af[dt][ks] = *(const bf16x8*)(vT + (size_t)(d0 + 16 * dt + fr) * T + tok0 + 32 * ks + 8 * fq);
    const float* lng = p->in[14] + (size_t)o * 2048; const float* lnb = p->in[15] + (size_t)o * 2048;
    const float* bs = p->in[17] + ((size_t)o * 8 + g) * 128;
    f32x4 g4[2], b4[2];
#pragma unroll
    for (int dt = 0; dt < 2; ++dt) { g4[dt] = *(const f32x4*)(lng + d0 + 16 * dt + 4 * fq); b4[dt] = *(const f32x4*)(lnb + d0 + 16 * dt + 4 * fq); }
    __syncthreads();
#pragma unroll
    for (int hf = 0; hf < 2; ++hf) {
      u32x2 uu[4][2]; float bsv[4];
#pragma unroll
      for (int i2 = 0; i2 < 4; ++i2) {
        const size_t tok = tok0 + 16 * (4 * hf + i2) + fr;
        bsv[i2] = bs[16 * (4 * hf + i2) + fr];
#pragma unroll
        for (int dt = 0; dt < 2; ++dt) {
          const int dc = d0 + 16 * dt + 4 * fq;
          uu[i2][dt] = *(const u32x2*)(ug + tok * 2048 + dc);
        }
      }
#pragma unroll
      for (int i2 = 0; i2 < 4; ++i2) {
        const int it = 4 * hf + i2;
        f32x4 acc0 = {0.f, 0.f, 0.f, 0.f}, acc1 = {0.f, 0.f, 0.f, 0.f};
#pragma unroll
        for (int ks = 0; ks < 4; ++ks) {
          const bf16x8 Bf = *(const bf16x8*)(wsS + (16 * it + fr) * 272 + (32 * ks + 8 * fq) * 2);
          acc0 = __builtin_amdgcn_mfma_f32_16x16x32_bf16(Af[0][ks], Bf, acc0, 0, 0, 0);
          acc1 = __builtin_amdgcn_mfma_f32_16x16x32_bf16(Af[1][ks], Bf, acc1, 0, 0, 0);
        }
        const int i = 16 * it + fr; const size_t tok = tok0 + i;
        const float c1 = c1S[i], c2 = c2S[i], bsi = bsv[i2];
#pragma unroll
        for (int dt = 0; dt < 2; ++dt) {
          const f32x4 a = dt ? acc1 : acc0;
          const int dc = d0 + 16 * dt + 4 * fq;
          const u32x2 u4 = uu[i2][dt];
          const float sv0 = g4[dt][0] * (a[0] - c1) + b4[dt][0] * c2 + bsi, sv1 = g4[dt][1] * (a[1] - c1) + b4[dt][1] * c2 + bsi;
          const float sv2 = g4[dt][2] * (a[2] - c1) + b4[dt][2] * c2 + bsi, sv3 = g4[dt][3] * (a[3] - c1) + b4[dt][3] * c2 + bsi;
          u32x2 o2;
          o2[0] = pk2(bflo(u4[0]) * sv0, bfhi(u4[0]) * sv1);
          o2[1] = pk2(bflo(u4[1]) * sv2, bfhi(u4[1]) * sv3);
          *(u32x2*)(yb + tok * 2048 + dc) = o2;
        }
      }
    }
  }
  __syncthreads();
}

#define XB_TMO      128
#define XB_XCNT(j)  (256  + 64 * (j))
#define XB_XSUB(j)  (1280 + 64 * (j))
#define XB_XGEN(j)  (2304 + 64 * (j))
#define XB_TOP      3328
#define XB_TOPGEN   3392
#define XCD_BAR_WORDS 3456
#define XB_SPIN_CAP (1u << 22)
DI unsigned xb_ld(unsigned* p)              { return __hip_atomic_load(p, __ATOMIC_RELAXED, __HIP_MEMORY_SCOPE_AGENT); }
DI unsigned xb_add(unsigned* p, unsigned v) { return __hip_atomic_fetch_add(p, v, __ATOMIC_RELAXED, __HIP_MEMORY_SCOPE_AGENT); }
DI unsigned xb_xcc_id() { return (unsigned)__builtin_amdgcn_s_getreg((3 << 11) | 20) & 0xFu; }
#define XB_SPIN(cond, bar) do { unsigned _sp = 0; while (cond) { __builtin_amdgcn_s_sleep(1); \
    if ((++_sp & 255u) == 0u) { if (xb_ld(&(bar)[XB_TMO])) break; if (_sp > XB_SPIN_CAP) { atomicAdd(&(bar)[XB_TMO], 1u); break; } } } } while (0)
struct XcdBarrier { unsigned* bar; unsigned x; volatile LAS unsigned* st; };
DI XcdBarrier xcd_barrier_post(unsigned* bar, volatile LAS unsigned* st) {
  XcdBarrier b; b.bar = bar; b.x = xb_xcc_id(); b.st = st;
  if (threadIdx.x == 0) (void)xb_add(&bar[XB_XCNT(b.x)], 1u);
  return b;
}
DI void xcd_barrier_complete(unsigned* bar, unsigned x, unsigned& nloc, unsigned& nx) {
  const unsigned G = gridDim.x * gridDim.y * gridDim.z;
  unsigned sum, cnt, mine, sp = 0u;
  for (;;) {
    sum = 0u; cnt = 0u; mine = 0u;
#pragma unroll
    for (unsigned j = 0; j < 16; ++j) { const unsigned c = xb_ld(&bar[XB_XCNT(j)]); sum += c; cnt += (c > 0u) ? 1u : 0u; mine = (j == x) ? c : mine; }
    if (sum == G) break;
    __builtin_amdgcn_s_sleep(1);
    if ((++sp & 255u) == 0u) { if (xb_ld(&bar[XB_TMO])) break; if (sp > XB_SPIN_CAP) { atomicAdd(&bar[XB_TMO], 1u); break; } }
  }
  nloc = mine > 0u ? mine : 1u; nx = cnt > 0u ? cnt : 1u;
}
DI void xcd_barrier(const XcdBarrier& b) {
  asm volatile("s_waitcnt vmcnt(0)" ::: "memory");
  __syncthreads();
  if (threadIdx.x == 0) {
    unsigned* bar = b.bar;
    __builtin_amdgcn_s_waitcnt(0);
    unsigned nloc = b.st[0], nx = b.st[1];
    if (nloc == 0u) { xcd_barrier_complete(bar, b.x, nloc, nx); b.st[0] = nloc; b.st[1] = nx; }
    const unsigned old = xb_add(&bar[XB_XSUB(b.x)], 1u);
    const unsigned gen = old / nloc;
    if (old + 1u == (gen + 1u) * nloc) {
      __builtin_amdgcn_fence(__ATOMIC_RELEASE, "agent");
      asm volatile("s_waitcnt vmcnt(0)" ::: "memory");
      const unsigned og = xb_add(&bar[XB_TOP], 1u);
      const unsigned tg = og / nx;
      if (og + 1u == (tg + 1u) * nx) xb_add(&bar[XB_TOPGEN], 1u);
      else XB_SPIN(xb_ld(&bar[XB_TOPGEN]) == tg, bar);
      __builtin_amdgcn_fence(__ATOMIC_ACQUIRE, "agent");
      xb_add(&bar[XB_XGEN(b.x)], 1u);
      asm volatile("s_waitcnt vmcnt(0)" ::: "memory");
    } else {
      XB_SPIN(xb_ld(&bar[XB_XGEN(b.x)]) == gen, bar);
      __builtin_amdgcn_fence(__ATOMIC_ACQUIRE, "agent");
      asm volatile("s_waitcnt vmcnt(0)" ::: "memory");
    }
  }
  __syncthreads();
}

DI bool get_gemm(KP p, int l, int slot, int gi, GemmDesc& d) {
  const bool even = (l & 1) == 0; const int li = l >> 1;
  bf16_t* W = (bf16_t*)(p->ws + B_W);
  bf16_t* hb = (bf16_t*)(p->ws + B_H);
  bf16_t* zb = (bf16_t*)(p->ws + B_Z);
  bf16_t* vt = (bf16_t*)(p->ws + B_VT);
  bf16_t* yb = (bf16_t*)(p->ws + B_Y);
  const float* st0 = (const float*)(p->ws + B_ST0); const float* st1 = (const float*)(p->ws + B_ST1);
  const bf16_t* WL = W + (even ? (size_t)li * EVEN_SZ : 2 * EVEN_SZ + (size_t)li * ODD_SZ);
  d.rs = nullptr; d.cs = nullptr; d.cst = nullptr; d.ugmode = 0;
  if (slot == 0) {
    if (gi >= 2) return false;
    if (even) {
      if (gi == 0) { d.A = hb; d.lda = 2048; d.Bt = WL + E_WIN; d.ldb = 2048; d.M = T; d.N = 5120; d.K = 2048; d.O = zb; d.ldc = 5120; }
      else { d.A = WL + E_WBV; d.lda = 2048; d.Bt = hb; d.ldb = 2048; d.M = 1024; d.N = T; d.K = 2048; d.O = vt; d.ldc = T; }
    } else {
      if (gi == 0) { d.A = hb; d.lda = 2048; d.Bt = WL + O_WUG; d.ldb = 2048; d.M = T; d.N = 4096; d.K = 2048; d.O = zb; d.ldc = 2048; d.ugmode = 1; }
      else { d.A = WL + O_WV; d.lda = 2048; d.Bt = hb; d.ldb = 2048; d.M = 2048; d.N = T; d.K = 2048; d.O = vt; d.ldc = T; d.cst = (float*)(p->ws + B_KR); }
    }
    return true;
  }
  if (slot == 2) {
    if (gi >= 3) return false;
    if (gi == 0) { d.A = zb; d.lda = 5120; d.Bt = WL + E_WUQ; d.ldb = 512; d.M = T; d.N = 1536; d.K = 512; d.O = (bf16_t*)(p->ws + B_Q); d.ldc = 1536; d.rs = st0; }
    else if (gi == 1) { d.A = zb + 512; d.lda = 5120; d.Bt = WL + E_WKN; d.ldb = 256; d.M = T; d.N = 1024; d.K = 256; d.O = (bf16_t*)(p->ws + B_KN); d.ldc = 1024; d.rs = st1; }
    else { d.A = WL + E_WV; d.lda = 256; d.Bt = zb + 512; d.ldb = 5120; d.M = 1024; d.N = T; d.K = 256; d.O = vt + (size_t)1024 * T; d.ldc = T; d.cs = st1; }
    return true;
  }
  if (gi >= 1) return false;
  d.A = yb; d.lda = 2048; d.Bt = WL + (even ? E_WOUT : O_WOUT); d.ldb = 2048; d.M = T; d.N = 2048; d.K = 2048; d.O = zb; d.ldc = 2048;
  return true;
}

__global__ void __launch_bounds__(512, 2) mega(Params p_arg, int ph_lo, int ph_hi, int coop) {
  extern __shared__ __attribute__((aligned(16))) unsigned char smem[];
  cg::grid_group grid = cg::this_grid();
  __shared__ uint4 xb_words;
  if (threadIdx.x == 0) xb_words = make_uint4(0u, 0u, 0u, 0u);
  __syncthreads();
  const XcdBarrier xb = xcd_barrier_post((unsigned*)(p_arg.ws + B_BAR), (volatile LAS unsigned*)&xb_words);
  bool first = true;
  for (int ph = ph_lo; ph < ph_hi; ++ph) {
    int l = 0, slot = -1;
    if (ph >= 2) { l = (ph - 2) / 6; slot = (ph - 2) % 6; }
    const bool even = (l & 1) == 0; const int li = l >> 1;
    if (ph >= 2 && !even && (slot == 3 || slot == 1)) continue;
    if (!first && coop) { if (coop == 2) grid.sync(); else xcd_barrier(xb); }
    first = false;
    KP p = (KP)__builtin_amdgcn_kernarg_segment_ptr();
    asm volatile("" : "+s"(p));
    if (ph == 0) {
#pragma unroll 1
      for (int rep = 0; rep < REP_PREP; ++rep) prep_phase(p, smem);
    } else if (ph == 1 || slot == 5) {
#ifndef DIS_ROWS
      if (ph == 1) rows_phase(p, -1, 0); else rows_phase(p, l, l + 1);
#endif
    } else if (slot == 0 || slot == 4 || (slot == 2 && even)) {
#ifndef DIS_GEMM
#pragma unroll 1
      for (int gi2 = 0; gi2 < 3 * REP_GEMM; ++gi2) {
        const int gi = gi2 / REP_GEMM;
        GemmDesc d;
        if (!get_gemm(p, l, slot, gi, d)) break;
        pg8::Gemm g{d.A, d.Bt, d.M, d.N, d.K, d.lda, d.ldb};
        pg8::StaticOrder S; S.init(d.M, d.N, (int)gridDim.x, (int)blockIdx.x);
        if (slot == 2 && gi == 1 && (gridDim.x & 1) == 0 && (int)gridDim.x * 2 > (d.M / 256) * (d.N / 256)) {
          const int half = (int)gridDim.x / 2;
          if ((int)blockIdx.x >= half) S.init(d.M, d.N, half, (int)blockIdx.x - half);
          else S.init(d.M, d.N, half, 1 << 28);
        }
        pg8::gemm_phase((LAS unsigned char*)smem, g, S, pg8::EpiBf16S{d.O, d.ldc, d.rs, d.cs, d.cst, T, d.ugmode});
        __syncthreads();
      }
#endif
    } else if (slot == 1) {
#pragma unroll 1
      for (int rep = 0; rep < REP_MISC; ++rep) even_stats_phase(p);
    } else if (slot == 2) {
#pragma unroll 1
      for (int rep = 0; rep < REP_MISC; ++rep) gating_phase(p, li, smem);
    } else if (slot == 3) {
      attn_phase<0>(p, li, smem);
#if PROBE_ATTN_MODE
      attn_phase<PROBE_ATTN_MODE>(p, li + 2, smem);
#endif
    }
  }
}

extern "C" void kernel_launch(void* const* d_in, const int* in_sizes, int n_in, void* d_out, int out_size, void* d_ws, size_t ws_size, hipStream_t stream) {
  constexpr size_t kDynLds = 131072;
  static int grid_blocks = 0;
  if (!grid_blocks) {
    (void)hipFuncSetAttribute((const void*)mega, hipFuncAttributeMaxDynamicSharedMemorySize, (int)kDynLds);
    int dev = 0, cus = 0, per_cu = 0;
    (void)hipGetDevice(&dev);
    (void)hipDeviceGetAttribute(&cus, hipDeviceAttributeMultiprocessorCount, dev);
    (void)hipOccupancyMaxActiveBlocksPerMultiprocessor(&per_cu, mega, 512, kDynLds);
    if (per_cu < 1) fprintf(stderr, "occupancy query returned %d\n", per_cu);
    grid_blocks = cus;
    if (ws_size < WS_NEED) fprintf(stderr, "workspace too small: %zu < %zu\n", ws_size, (size_t)WS_NEED);
  }
  Params p{};
  for (int i = 0; i < 19; ++i) p.in[i] = (const float*)d_in[i];
  p.out = (float*)d_out; p.ws = (unsigned char*)d_ws;
  (void)hipMemsetAsync((unsigned char*)d_ws + B_BAR, 0, ZERO_BYTES, stream);
  int ph_lo = 0, ph_hi = 26, coop = 1;
  void* args[] = {&p, &ph_lo, &ph_hi, &coop};
  hipError_t e = hipLaunchCooperativeKernel((void*)mega, dim3(grid_blocks), dim3(512), args, kDynLds, stream);
  if (e != hipSuccess) fprintf(stderr, "cooperative launch failed: %s (grid %d)\n", hipGetErrorString(e), grid_blocks);
}
```

```cpp
#include <hip/hip_runtime.h>
#include <hip/hip_cooperative_groups.h>
#include <cstdio>
namespace cg = cooperative_groups;
#define REP_GEMM 1
#define PROBE_ATTN_MODE 0
#define REP_MISC 1
#define REP_PREP 1

#define LAS __attribute__((address_space(3)))
#define DI __device__ __forceinline__
typedef unsigned short bf16_t;
typedef short bf16x8 __attribute__((ext_vector_type(8)));
typedef float f32x4 __attribute__((ext_vector_type(4)));
typedef float f32x16 __attribute__((ext_vector_type(16)));
typedef float f32x2 __attribute__((ext_vector_type(2)));
typedef __bf16 bf16x2_t __attribute__((ext_vector_type(2)));
typedef unsigned u32x4 __attribute__((ext_vector_type(4)));
typedef unsigned u32x2 __attribute__((ext_vector_type(2)));

DI unsigned pk2(float lo, float hi) { f32x2 v = {lo, hi}; return __builtin_bit_cast(unsigned, __builtin_convertvector(v, bf16x2_t)); }
DI float bflo(unsigned u) { return __uint_as_float(u << 16); }
DI float bfhi(unsigned u) { return __uint_as_float(u & 0xffff0000u); }
DI float bf1(unsigned short s) { return __uint_as_float(((unsigned)s) << 16); }
DI float silu_f(float x) { return x * __builtin_amdgcn_rcpf(1.0f + __builtin_amdgcn_exp2f(-1.44269504f * x)); }
DI int get_tid() { int t = threadIdx.x; asm volatile("" : "+v"(t)); return t; }
DI float max3f(float a, float b, float c) { return __builtin_amdgcn_fmed3f(__builtin_amdgcn_fmed3f(a, b, __builtin_inff()), c, __builtin_inff()); }
DI float wave_sum(float v) {
#pragma unroll
  for (int o = 32; o > 0; o >>= 1) v += __shfl_xor(v, o);
  return v;
}

constexpr int T = 16384, DM = 2048, SEQ = 2048;
constexpr float EPS = 1e-6f;
constexpr float LOG2E = 1.44269504088896f;

constexpr size_t E_WIN = 0, E_WBV = E_WIN + (size_t)5120 * 2048, E_WUQ = E_WBV + (size_t)1024 * 2048, E_WKN = E_WUQ + (size_t)1536 * 512,
                 E_WV = E_WKN + (size_t)1024 * 256, E_WOUT = E_WV + (size_t)1024 * 256, EVEN_SZ = E_WOUT + (size_t)2048 * 2048;
constexpr size_t O_WUG = 0, O_WV = O_WUG + (size_t)4096 * 2048, O_WOUT = O_WV + (size_t)2048 * 2048, ODD_SZ = O_WOUT + (size_t)2048 * 2048;
constexpr size_t W_TOTAL = 2 * EVEN_SZ + 2 * ODD_SZ;
constexpr size_t al256(size_t x) { return (x + 255) & ~(size_t)255; }
constexpr size_t B_W = 0;
constexpr size_t B_MOD = al256(B_W + W_TOTAL * 2);
constexpr size_t B_COS = al256(B_MOD + (size_t)4 * 8 * 6144 * 4);
constexpr size_t B_SIN = al256(B_COS + (size_t)2048 * 32 * 4);
constexpr size_t B_H = al256(B_SIN + (size_t)2048 * 32 * 4);
constexpr size_t B_Z = al256(B_H + (size_t)T * 2048 * 2);
constexpr size_t B_VT = al256(B_Z + (size_t)T * 5120 * 2);
constexpr size_t B_Q = al256(B_VT + (size_t)2048 * T * 2);
constexpr size_t B_KN = al256(B_Q + (size_t)T * 1536 * 2);
constexpr size_t B_KR = al256(B_KN + (size_t)T * 1024 * 2);
constexpr size_t B_ST0 = al256(B_KR + (size_t)T * 64 * 2);
constexpr size_t B_ST1 = al256(B_ST0 + (size_t)T * 4);
constexpr size_t B_Y = al256(B_ST1 + (size_t)T * 4);
constexpr size_t B_XB = al256(B_Y + (size_t)T * 2048 * 2);
constexpr size_t B_BAR = al256(B_XB + (size_t)T * 2048 * 2);
constexpr size_t B_CTR = B_BAR + 16384;
constexpr size_t ZERO_BYTES = 16384 + 256;
constexpr size_t WS_NEED = B_CTR + 256;

struct Params { const float* in[19]; float* out; unsigned char* ws; };
typedef const __attribute__((address_space(4))) Params* KP;

struct Seg { int in_idx; long src_off; int ld; int K; int nrows; long dst_off; int sc_idx; int sc_off; int tile0; int split; };
constexpr int NSEG_MAX = 64;
struct SegTab { Seg s[NSEG_MAX]; int n; int ntiles; };
constexpr SegTab make_segtab() {
  SegTab t{};
  int n = 0;
  for (int e = 0; e < 2; ++e) {
    const long WE = (long)(e * EVEN_SZ);
    const long so = (long)e * 2048 * 5952;
    t.s[n++] = Seg{6, so + 0, 5952, 2048, 832, WE + (long)E_WIN, -1, 0, 0};
    t.s[n++] = Seg{-1, 0, 5952, 2048, 192, WE + (long)E_WIN + 832L * 2048, -1, 0, 0};
    t.s[n++] = Seg{6, so + 832, 5952, 2048, 2048, WE + (long)E_WIN + 1024L * 2048, -1, 0, 0};
    t.s[n++] = Seg{6, so + 3904, 5952, 2048, 2048, WE + (long)E_WIN + 3072L * 2048, -1, 0, 0};
    t.s[n++] = Seg{6, so + 2880, 5952, 2048, 1024, WE + (long)E_WBV, -1, 0, 0};
    t.s[n++] = Seg{8, (long)e * 512 * 1536, 1536, 512, 1536, WE + (long)E_WUQ, 7, e * 512, 0};
    for (int hh = 0; hh < 8; ++hh) {
      t.s[n++] = Seg{10, (long)e * 256 * 2048 + hh * 256, 2048, 256, 128, WE + (long)E_WKN + (long)hh * 128 * 256, 9, e * 256, 0};
      t.s[n++] = Seg{10, (long)e * 256 * 2048 + hh * 256 + 128, 2048, 256, 128, WE + (long)E_WV + (long)hh * 128 * 256, 9, e * 256, 0};
    }
    t.s[n++] = Seg{12, (long)e * 2048 * 2048, 2048, 2048, 2048, WE + (long)E_WOUT, -1, 0, 0};
  }
  for (int o = 0; o < 2; ++o) {
    const long WO = (long)(2 * EVEN_SZ + o * ODD_SZ);
    const long so = (long)o * 2048 * 6144;
    t.s[n++] = Seg{13, so + 0, 6144, 2048, 4096, WO + (long)O_WUG, -1, 0, 0, 1};
    t.s[n++] = Seg{13, so + 2048, 6144, 2048, 2048, WO + (long)O_WV, -1, 0, 0};
    t.s[n++] = Seg{18, (long)o * 2048 * 2048, 2048, 2048, 2048, WO + (long)O_WOUT, -1, 0, 0};
  }
  int tiles = 0;
  for (int i = 0; i < n; ++i) { t.s[i].tile0 = tiles; tiles += (t.s[i].nrows / 64) * (t.s[i].K / 256); }
  t.n = n; t.ntiles = tiles;
  return t;
}
__constant__ SegTab c_segtab = make_segtab();
constexpr int NT_W = make_segtab().ntiles;
constexpr int N_MODITEMS = 4 * 96;
constexpr int N_ROPEITEMS = 128;
constexpr int N_PREP = NT_W + N_MODITEMS + N_ROPEITEMS;

namespace pg8 {
constexpr int BM = 256, BK = 64, HALF = 128, HTB = HALF * BK * 2, STAGE_BYTES = 8 * HTB, NXCD = 8, WGM = 8;
DI int lds_byte(int r, int c) { const int st = (r >> 4) * 2 + (c >> 5), rr = r & 15, cc = c & 31, ob = rr * 64 + cc * 2; return st * 1024 + (ob ^ (((ob >> 9) & 1) << 5)); }
DI void stage_rc(int b, int& R, int& C) { const int st = b / 1024, sb = b % 1024, swz = sb ^ (((sb >> 9) & 1) << 5); R = (st >> 1) * 16 + swz / 64; C = (st & 1) * 32 + (swz % 64) / 2; }
DI int perm32(int rho) { const int n = rho >> 4, i = rho & 15; return 8 * (i >> 2) + 4 * n + (i & 3); }
struct Unit { int pm, pn; };
struct Gemm { const bf16_t* A; const bf16_t* Bt; int M, N, K, lda, ldb; };
struct StaticOrder {
  int nM, nN, nwg, G, c, nig, step;
  mutable int rem, gid, cnt;
  DI void init(int M, int N, int G_, int c_) {
    nM = M / BM; nN = N / BM; nwg = nM * nN; G = G_; c = c_; nig = WGM * nN; step = G / NXCD;
    const int q = nwg / NXCD, wgid0 = (c & (NXCD - 1)) * q + (c >> 3);
    gid = (c < nwg) ? wgid0 / nig : 0; rem = (c < nwg) ? wgid0 - gid * nig : 0; cnt = 0;
  }
  DI bool next(int i, Unit& u) const {
    if ((long)i * G + c >= nwg) return false;
    if (i != 0) { rem += step; while (rem >= nig) { rem -= nig; ++gid; } }
    const int fm = gid * WGM, gsz = (nM - fm) < WGM ? (nM - fm) : WGM;
    const int sh = 31 - __builtin_clz(gsz);
    u.pm = fm + (rem & (gsz - 1)); u.pn = rem >> sh; return true;
  }
};
struct EpiBf16S {
  static constexpr bool PERM = true;
  bf16_t* O; int ldc; const float* rs; const float* cs; float* cst; int cst_ld; int ugmode;
  DI void operator()(const f32x4 (&acc)[2][2][4][2], const Unit& u, int wr, int wc, int fr, int fq) const {
    const int row0 = u.pm * BM + wr * 64 + fr, col0 = u.pn * BM + wc * 64 + 8 * fq;
    if (ugmode) {
      const int oc = u.pn * 128 + wc * 32 + 8 * fq;
#pragma unroll
      for (int ai = 0; ai < 2; ++ai)
#pragma unroll
        for (int m = 0; m < 4; ++m) {
          const int row = row0 + ai * HALF + m * 16;
          const f32x4 u0 = acc[ai][0][m][0], u1 = acc[ai][0][m][1], g0 = acc[ai][1][m][0], g1 = acc[ai][1][m][1];
          u32x4 o;
          o[0] = pk2(u0[0] * silu_f(g0[0]), u0[1] * silu_f(g0[1])); o[1] = pk2(u0[2] * silu_f(g0[2]), u0[3] * silu_f(g0[3]));
          o[2] = pk2(u1[0] * silu_f(g1[0]), u1[1] * silu_f(g1[1])); o[3] = pk2(u1[2] * silu_f(g1[2]), u1[3] * silu_f(g1[3]));
          *(u32x4*)(O + (size_t)row * ldc + oc) = o;
        }
      return;
    }
#pragma unroll
    for (int ai = 0; ai < 2; ++ai)
#pragma unroll
      for (int m = 0; m < 4; ++m) {
        const int row = row0 + ai * HALF + m * 16;
        float r = 1.0f;
        if (rs) r = rs[row];
        bf16_t* rowp = O + (size_t)row * ldc + col0;
#pragma unroll
        for (int bj = 0; bj < 2; ++bj) {
          f32x4 v0 = acc[ai][bj][m][0] * r, v1 = acc[ai][bj][m][1] * r;
          if (cs) { v0 *= *(const f32x4*)(cs + col0 + 32 * bj); v1 *= *(const f32x4*)(cs + col0 + 32 * bj + 4); }
          u32x4 o; o[0] = pk2(v0[0], v0[1]); o[1] = pk2(v0[2], v0[3]); o[2] = pk2(v1[0], v1[1]); o[3] = pk2(v1[2], v1[3]);
          *(u32x4*)(rowp + 32 * bj) = o;
        }
      }
    if (cst) {
#pragma unroll
      for (int bj = 0; bj < 2; ++bj) {
        f32x4 s0 = {0.f, 0.f, 0.f, 0.f}, s1 = s0, q0 = s0, q1 = s0;
#pragma unroll
        for (int ai = 0; ai < 2; ++ai)
#pragma unroll
          for (int m = 0; m < 4; ++m) {
            const f32x4 v0 = acc[ai][bj][m][0], v1 = acc[ai][bj][m][1];
            s0 += v0; s1 += v1; q0 += v0 * v0; q1 += v1 * v1;
          }
#pragma unroll
        for (int off = 1; off < 16; off <<= 1)
#pragma unroll
          for (int e = 0; e < 4; ++e) {
            s0[e] += __shfl_xor(s0[e], off); s1[e] += __shfl_xor(s1[e], off);
            q0[e] += __shfl_xor(q0[e], off); q1[e] += __shfl_xor(q1[e], off);
          }
        if (fr == 0) {
          float* bp = cst + (size_t)((u.pm * 2 + wr) * 2) * cst_ld + col0 + 32 * bj;
          *(f32x4*)bp = s0; *(f32x4*)(bp + 4) = s1;
          *(f32x4*)(bp + cst_ld) = q0; *(f32x4*)(bp + cst_ld + 4) = q1;
        }
      }
    }
  }
};

typedef EpiBf16S Epi;
DI void gemm_phase(LAS unsigned char* lds, const Gemm g, const StaticOrder& S, const Epi& E) {
  const int tid = get_tid(), wid = __builtin_amdgcn_readfirstlane(tid >> 6), lane = tid & 63, wr = wid >> 2, wc = wid & 3, fr = lane & 15, fq = lane >> 4;
  const int K = g.K, nt = K / BK;
  unsigned voffA[2], voffB0[2], voffB1[2];
#pragma unroll
  for (int i = 0; i < 2; ++i) { int R, C; stage_rc(tid * 16 + i * 8192, R, C);
    const int Rb = 64 * (R >> 5) + 8 * ((R & 15) >> 2) + 4 * ((R >> 4) & 1) + (R & 3);
    voffA[i] = (unsigned)(R * g.lda + C) * 2u; voffB0[i] = (unsigned)(Rb * g.ldb + C) * 2u; voffB1[i] = (unsigned)((Rb + 32) * g.ldb + C) * 2u; }
  const size_t kstep = (size_t)(BK * 2);
  const size_t hstepA = (size_t)HALF * g.lda * 2, hstepB = (size_t)HALF * g.ldb * 2;
  const size_t tstepA = 2 * hstepA, tstepB = 2 * hstepB;
  const unsigned ldsw = (unsigned)wid * 1024u;
  const int aoff = lds_byte(wr * 64 + fr, fq * 8), boff = lds_byte(wc * 32 + fr, fq * 8);
#define PG8_SA(b, h) (((b) * 2 + (h)) * HTB)
#define PG8_SB(b, h) ((4 + (b) * 2 + (h)) * HTB)
#define PG8_STAGE(bufoff, gbase, voff) do { _Pragma("unroll") for (int _i = 0; _i < 2; ++_i) \
    __builtin_amdgcn_global_load_lds((const unsigned*)((const char*)(gbase) + (voff)[_i]), (LAS unsigned*)(lds + (bufoff) + ldsw + _i * 8192), 16, 0, 0); } while (0)
#define PG8_LDA(dst, b, h) do { _Pragma("unroll") for (int m = 0; m < 4; ++m) _Pragma("unroll") for (int k = 0; k < 2; ++k) dst[m][k] = *(const LAS bf16x8*)(lds + PG8_SA(b, h) + aoff + m * 2048 + k * 1024); } while (0)
#define PG8_LDB(dst, b, h) do { _Pragma("unroll") for (int n = 0; n < 2; ++n) _Pragma("unroll") for (int k = 0; k < 2; ++k) dst[n][k] = *(const LAS bf16x8*)(lds + PG8_SB(b, h) + boff + n * 2048 + k * 1024); } while (0)
#define PG8_MMA(ai, bj, At, Bt) do { __builtin_amdgcn_s_setprio(1); _Pragma("unroll") for (int m = 0; m < 4; ++m) _Pragma("unroll") for (int n = 0; n < 2; ++n) _Pragma("unroll") for (int k = 0; k < 2; ++k) \
    acc[ai][bj][m][n] = __builtin_amdgcn_mfma_f32_16x16x32_bf16(Bt[n][k], At[m][k], acc[ai][bj][m][n], 0, 0, 0); __builtin_amdgcn_s_setprio(0); } while (0)
#define PG8_WAIT_V(n) asm volatile("s_waitcnt vmcnt(" #n ")" ::: "memory")
#define PG8_WAIT_L(n) asm volatile("s_waitcnt lgkmcnt(" #n ")" ::: "memory")
#define PG8_BAR __builtin_amdgcn_s_barrier()
#define PG8_SCHED __builtin_amdgcn_sched_barrier(0)
  Unit cur, nxt; int ui = 0;
  if (!S.next(0, cur)) return;
  f32x4 acc[2][2][4][2];
#pragma unroll
  for (int a = 0; a < 2; ++a)
#pragma unroll
    for (int b = 0; b < 2; ++b)
#pragma unroll
      for (int m = 0; m < 4; ++m)
#pragma unroll
        for (int n = 0; n < 2; ++n) acc[a][b][m][n] = (f32x4){0.f, 0.f, 0.f, 0.f};
  bf16x8 At[4][2], B0[2][2], B1[2][2];
  const char* cA = (const char*)g.A + (size_t)cur.pm * tstepA; const char* cB = (const char*)g.Bt + (size_t)cur.pn * tstepB;
  PG8_STAGE(PG8_SB(0, 0), cB, voffB0); PG8_STAGE(PG8_SA(0, 0), cA, voffA); PG8_STAGE(PG8_SB(0, 1), cB, voffB1); PG8_STAGE(PG8_SA(0, 1), cA + hstepA, voffA);
  if (wr == 1) PG8_BAR;
  PG8_WAIT_V(4); PG8_BAR;
  PG8_STAGE(PG8_SB(1, 0), cB + kstep, voffB0); PG8_STAGE(PG8_SA(1, 0), cA + kstep, voffA); PG8_STAGE(PG8_SB(1, 1), cB + kstep, voffB1);
  PG8_WAIT_V(6); PG8_BAR;
  for (;;) {
    const bool has_next = S.next(ui + 1, nxt);
    const char* nA = has_next ? (const char*)g.A + (size_t)nxt.pm * tstepA : cA; const char* nB = has_next ? (const char*)g.Bt + (size_t)nxt.pn * tstepB : cB;
    for (int t = 0; t < nt; t += 2) {
      const bool last = (t == nt - 2);
      const char* a1 = cA + (size_t)(t + 1) * kstep;
      const char* a2 = last ? nA : cA + (size_t)(t + 2) * kstep; const char* b2 = last ? nB : cB + (size_t)(t + 2) * kstep;
      const char* a3 = a2 + kstep; const char* b3 = b2 + kstep;
      PG8_LDB(B0, 0, 0); PG8_SCHED; PG8_LDA(At, 0, 0); PG8_STAGE(PG8_SA(1, 1), a1 + hstepA, voffA);
      PG8_WAIT_L(8); PG8_BAR; PG8_WAIT_L(0); PG8_MMA(0, 0, At, B0); PG8_BAR; PG8_SCHED;
      PG8_LDB(B1, 0, 1); PG8_STAGE(PG8_SB(0, 0), b2, voffB0);
      PG8_BAR; PG8_WAIT_L(0); PG8_MMA(0, 1, At, B1); PG8_BAR;
      PG8_LDA(At, 0, 1); PG8_STAGE(PG8_SA(0, 0), a2, voffA);
      PG8_BAR; PG8_WAIT_L(0); PG8_MMA(1, 0, At, B0); PG8_BAR; PG8_SCHED;
      PG8_STAGE(PG8_SB(0, 1), b2, voffB1);
      PG8_WAIT_V(6); PG8_BAR; PG8_MMA(1, 1, At, B1); PG8_BAR;
      PG8_LDB(B0, 1, 0); PG8_SCHED; PG8_LDA(At, 1, 0); PG8_STAGE(PG8_SA(0, 1), a2 + hstepA, voffA);
      PG8_WAIT_L(8); PG8_BAR; PG8_WAIT_L(0); PG8_MMA(0, 0, At, B0); PG8_BAR; PG8_SCHED;
      PG8_LDB(B1, 1, 1); PG8_STAGE(PG8_SB(1, 0), b3, voffB0);
      PG8_BAR; PG8_WAIT_L(0); PG8_MMA(0, 1, At, B1); PG8_BAR;
      PG8_LDA(At, 1, 1); PG8_STAGE(PG8_SA(1, 0), a3, voffA);
      PG8_BAR; PG8_WAIT_L(0); PG8_MMA(1, 0, At, B0); PG8_BAR; PG8_SCHED;
      PG8_STAGE(PG8_SB(1, 1), b3, voffB1);
      PG8_WAIT_V(6); PG8_BAR; PG8_MMA(1, 1, At, B1); PG8_BAR;
    }
    E(acc, cur, wr, wc, fr, fq);
    if (!has_next) break;
#pragma unroll
    for (int a = 0; a < 2; ++a)
#pragma unroll
      for (int b = 0; b < 2; ++b)
#pragma unroll
        for (int m = 0; m < 4; ++m)
#pragma unroll
          for (int n = 0; n < 2; ++n) acc[a][b][m][n] = (f32x4){0.f, 0.f, 0.f, 0.f};
    cur = nxt; cA = nA; cB = nB; ++ui;
  }
  PG8_WAIT_V(0);
  if (wr == 0) PG8_BAR;
  PG8_BAR;
#undef PG8_SA
#undef PG8_SB
#undef PG8_STAGE
#undef PG8_LDA
#undef PG8_LDB
#undef PG8_MMA
#undef PG8_WAIT_V
#undef PG8_WAIT_L
#undef PG8_BAR
#undef PG8_SCHED
}
}

struct GemmDesc { const bf16_t* A; const bf16_t* Bt; bf16_t* O; const float* rs; const float* cs; float* cst; int lda, ldb, M, N, K, ldc, ugmode; };

__device__ void prep_transpose_tile(KP p, int tile, unsigned char* smem) {
  int si = 0;
  const int nseg = c_segtab.n;
  for (int i = 1; i < nseg; ++i) if (c_segtab.s[i].tile0 <= tile) si = i;
  const Seg sg = c_segtab.s[si];
  const int lt = tile - sg.tile0, nkt = sg.K / 256, nt_ = lt / nkt, kt_ = lt % nkt;
  const int n0 = nt_ * 64, k0 = kt_ * 256, tid = get_tid();
  constexpr int RS = 129;
  unsigned* L = (unsigned*)smem;
  bf16_t* dst = (bf16_t*)(p->ws + B_W) + sg.dst_off;
  if (sg.in_idx >= 0) {
    const float* src = p->in[sg.in_idx] + sg.src_off;
    const int kk2 = tid >> 4, nq = tid & 15;
    f32x4 r0[4], r1[4];
    const int scol = sg.split ? ((n0 >> 6) * 32 + ((4 * nq) & 31) + ((4 * nq) >> 5) * 4096) : (n0 + 4 * nq);
#pragma unroll
    for (int sub = 0; sub < 4; ++sub) {
      const int k = k0 + 64 * sub + 2 * kk2;
      r0[sub] = *(const f32x4*)(src + (size_t)k * sg.ld + scol);
      r1[sub] = *(const f32x4*)(src + (size_t)(k + 1) * sg.ld + scol);
    }
    if (sg.sc_idx >= 0) {
      const float* sc = p->in[sg.sc_idx] + sg.sc_off;
#pragma unroll
      for (int sub = 0; sub < 4; ++sub) { const int k = k0 + 64 * sub + 2 * kk2; r0[sub] *= sc[k]; r1[sub] *= sc[k + 1]; }
    }
#pragma unroll
    for (int sub = 0; sub < 4; ++sub)
#pragma unroll
      for (int e = 0; e < 4; ++e) L[(4 * nq + e) * RS + sub * 32 + kk2] = pk2(r0[sub][e], r1[sub][e]);
  } else {
    for (int i = tid; i < 64 * RS; i += 512) L[i] = 0u;
  }
  __syncthreads();
  {
    const int n = tid >> 3, kq = tid & 7;
#pragma unroll
    for (int j = 0; j < 4; ++j) {
      const int c = kq + 8 * j;
      u32x4 o; o[0] = L[n * RS + 4 * c]; o[1] = L[n * RS + 4 * c + 1]; o[2] = L[n * RS + 4 * c + 2]; o[3] = L[n * RS + 4 * c + 3];
      *(u32x4*)(dst + (size_t)(n0 + n) * sg.K + k0 + 8 * c) = o;
    }
  }
  __syncthreads();
}

__device__ void prep_mod_item(KP p, int item, unsigned char* smem) {
  const int l = item / 96, cc = item % 96, tid = get_tid();
  float* csL = (float*)smem;
  float* red = (float*)(smem + 65536);
  const float* c = p->in[1];
  for (int i = tid; i < 8 * 2048; i += 512) csL[i] = silu_f(c[i]);
  __syncthreads();
  const int cq = tid & 15, kg = tid >> 4;
  const float* w = p->in[2] + ((size_t)l * 2048 + (size_t)kg * 64) * 6144 + cc * 64 + 4 * cq;
  f32x4 acc[8];
#pragma unroll
  for (int b = 0; b < 8; ++b) acc[b] = (f32x4){0.f, 0.f, 0.f, 0.f};
#pragma unroll 8
  for (int kk = 0; kk < 64; ++kk) {
    const f32x4 wv = *(const f32x4*)(w + (size_t)kk * 6144);
    const int k = kg * 64 + kk;
#pragma unroll
    for (int b = 0; b < 8; ++b) acc[b] += wv * csL[b * 2048 + k];
  }
#pragma unroll
  for (int b = 0; b < 8; ++b) *(f32x4*)(red + ((kg * 8 + b) * 64 + 4 * cq)) = acc[b];
  __syncthreads();
  {
    const int b = tid >> 6, col = tid & 63;
    float s = 0.f;
    for (int k2 = 0; k2 < 32; ++k2) s += red[(k2 * 8 + b) * 64 + col];
    float* mod = (float*)(p->ws + B_MOD);
    mod[((size_t)l * 8 + b) * 6144 + cc * 64 + col] = s + p->in[3][(size_t)l * 6144 + cc * 64 + col];
  }
  __syncthreads();
}

__device__ void prep_phase(KP p, unsigned char* smem) {
  const int tid0 = get_tid();
  for (int it = blockIdx.x; it < N_PREP; it += gridDim.x) {
    if (it < N_MODITEMS) prep_mod_item(p, it, smem);
    else if (it < N_MODITEMS + NT_W) prep_transpose_tile(p, it - N_MODITEMS, smem);
    else {
      const int idx = (it - N_MODITEMS - NT_W) * 512 + tid0;
      const int pos = idx >> 5, i = idx & 31;
      const float freq = powf(10000.0f, -(float)i / 32.0f);
      const float ang = (float)pos * freq;
      ((float*)(p->ws + B_COS))[idx] = cosf(ang);
      ((float*)(p->ws + B_SIN))[idx] = sinf(ang);
    }
  }
}

__device__ void rows_phase(KP p, int l_done, int l_next) {
  const int tid = get_tid(), w = __builtin_amdgcn_readfirstlane(tid >> 6), lane = tid & 63;
  const float* mod = (const float*)(p->ws + B_MOD);
  const bf16_t* yo = (const bf16_t*)(p->ws + B_Z);
  bf16_t* hb = (bf16_t*)(p->ws + B_H);
  bf16_t* xb = (bf16_t*)(p->ws + B_XB);
  const float* xin = p->in[0];
  float* xout = p->out;
  const bool in_bf = l_done >= 1, out_f32 = l_done == 3;
  for (int base = blockIdx.x * 64; base < T; base += gridDim.x * 64) {
    const int row0 = base + w * 8, b = row0 >> 11;
    f32x4 gg[8], pa[8], pb[8];
    if (l_done >= 0) {
      const float* gp = p->in[5] + (size_t)l_done * DM;
      const float* gt = mod + ((size_t)l_done * 8 + b) * 6144 + 4096;
#pragma unroll
      for (int i = 0; i < 8; ++i) { const int c = 8 * (lane + 64 * (i >> 1)) + 4 * (i & 1); gg[i] = *(const f32x4*)(gp + c) * *(const f32x4*)(gt + c); }
    }
    if (l_next < 4) {
      const float* gp = p->in[4] + (size_t)l_next * DM;
      const float* sh = mod + ((size_t)l_next * 8 + b) * 6144;
#pragma unroll
      for (int i = 0; i < 8; ++i) { const int c = 8 * (lane + 64 * (i >> 1)) + 4 * (i & 1); pa[i] = *(const f32x4*)(gp + c) * (*(const f32x4*)(sh + 2048 + c) + 1.0f); pb[i] = *(const f32x4*)(sh + c); }
    }
    f32x4 xn[8]; u32x4 yn[4];
#pragma unroll
    for (int i = 0; i < 4; ++i) {
      const size_t o = (size_t)row0 * DM + 8 * (lane + 64 * i);
      if (in_bf) xn[i] = *(const f32x4*)(xb + o);
      else { xn[2 * i] = *(const f32x4*)(xin + o); xn[2 * i + 1] = *(const f32x4*)(xin + o + 4); }
      if (l_done >= 0) yn[i] = *(const u32x4*)(yo + o);
    }
#pragma unroll 1
    for (int k = 0; k < 8; ++k) {
      const int row = row0 + k;
      f32x4 xv[8]; u32x4 yr[4];
      if (in_bf) {
#pragma unroll
        for (int i = 0; i < 4; ++i) {
          const u32x4 r = __builtin_bit_cast(u32x4, xn[i]);
          xv[2 * i] = (f32x4){bflo(r[0]), bfhi(r[0]), bflo(r[1]), bfhi(r[1])};
          xv[2 * i + 1] = (f32x4){bflo(r[2]), bfhi(r[2]), bflo(r[3]), bfhi(r[3])};
        }
      } else {
#pragma unroll
        for (int i = 0; i < 8; ++i) xv[i] = xn[i];
      }
#pragma unroll
      for (int i = 0; i < 4; ++i) yr[i] = yn[i];
      if (k < 7) {
#pragma unroll
        for (int i = 0; i < 4; ++i) {
          const size_t o = (size_t)(row + 1) * DM + 8 * (lane + 64 * i);
          if (in_bf) xn[i] = *(const f32x4*)(xb + o);
          else { xn[2 * i] = *(const f32x4*)(xin + o); xn[2 * i + 1] = *(const f32x4*)(xin + o + 4); }
          if (l_done >= 0) yn[i] = *(const u32x4*)(yo + o);
        }
      }
      if (l_done >= 0) {
        float ss = 0.f;
#pragma unroll
        for (int i = 0; i < 4; ++i)
#pragma unroll
          for (int j = 0; j < 4; ++j) { const float lo = bflo(yr[i][j]), hi = bfhi(yr[i][j]); ss += lo * lo + hi * hi; }
        ss = wave_sum(ss);
        const float rinv = rsqrtf(ss * (1.0f / DM) + EPS);
#pragma unroll
        for (int i = 0; i < 4; ++i) {
          const f32x4 y0 = {bflo(yr[i][0]), bfhi(yr[i][0]), bflo(yr[i][1]), bfhi(yr[i][1])}, y1 = {bflo(yr[i][2]), bfhi(yr[i][2]), bflo(yr[i][3]), bfhi(yr[i][3])};
          xv[2 * i] += gg[2 * i] * (y0 * rinv); xv[2 * i + 1] += gg[2 * i + 1] * (y1 * rinv);
        }
        if (out_f32) {
#pragma unroll
          for (int i = 0; i < 8; ++i) *(f32x4*)(xout + (size_t)row * DM + 8 * (lane + 64 * (i >> 1)) + 4 * (i & 1)) = xv[i];
        } else {
#pragma unroll
          for (int i = 0; i < 4; ++i) {
            u32x4 o; o[0] = pk2(xv[2 * i][0], xv[2 * i][1]); o[1] = pk2(xv[2 * i][2], xv[2 * i][3]); o[2] = pk2(xv[2 * i + 1][0], xv[2 * i + 1][1]); o[3] = pk2(xv[2 * i + 1][2], xv[2 * i + 1][3]);
            *(u32x4*)(xb + (size_t)row * DM + 8 * (lane + 64 * i)) = o;
          }
        }
      }
      if (l_next < 4) {
        float ss = 0.f;
#pragma unroll
        for (int i = 0; i < 8; ++i) ss += xv[i][0] * xv[i][0] + xv[i][1] * xv[i][1] + xv[i][2] * xv[i][2] + xv[i][3] * xv[i][3];
        ss = wave_sum(ss);
        const float rinv = rsqrtf(ss * (1.0f / DM) + EPS);
#pragma unroll
        for (int i = 0; i < 4; ++i) {
          const int c = 8 * (lane + 64 * i);
          u32x4 o;
#pragma unroll
          for (int hlf = 0; hlf < 2; ++hlf) {
            const f32x4 hv = (xv[2 * i + hlf] * rinv) * pa[2 * i + hlf] + pb[2 * i + hlf];
            o[2 * hlf] = pk2(hv[0], hv[1]); o[2 * hlf + 1] = pk2(hv[2], hv[3]);
          }
          *(u32x4*)(hb + (size_t)row * DM + c) = o;
        }
      }
    }
  }
}

__device__ void even_stats_phase(KP p) {
  const int tid = get_tid(), w = tid >> 6, lane = tid & 63;
  const bf16_t* z1 = (const bf16_t*)(p->ws + B_Z);
  float* rsq = (float*)(p->ws + B_ST0); float* rskv = (float*)(p->ws + B_ST1);
  bf16_t* kr = (bf16_t*)(p->ws + B_KR);
  const float* cosT = (const float*)(p->ws + B_COS); const float* sinT = (const float*)(p->ws + B_SIN);
  for (int base = blockIdx.x * 64; base < T; base += gridDim.x * 64) {
    const int t0 = base + w * 8;
    u32x4 a[8]; u32x2 c[8]; unsigned short kq[8]; float cs[8], sn[8];
#pragma unroll
    for (int k = 0; k < 8; ++k) {
      const bf16_t* zr = z1 + (size_t)(t0 + k) * 5120;
      a[k] = *(const u32x4*)(zr + 8 * lane);
      c[k] = *(const u32x2*)(zr + 512 + 4 * lane);
      kq[k] = zr[768 + lane];
      const int pos = (t0 + k) & (SEQ - 1);
      cs[k] = cosT[pos * 32 + (lane & 31)]; sn[k] = sinT[pos * 32 + (lane & 31)];
    }
#pragma unroll
    for (int k = 0; k < 8; ++k) {
      const int t = t0 + k;
      const float kv = bf1(kq[k]);
      float s1 = 0.f, s2 = 0.f;
#pragma unroll
      for (int i = 0; i < 4; ++i) { const float lo = bflo(a[k][i]), hi = bfhi(a[k][i]); s1 += lo * lo + hi * hi; }
#pragma unroll
      for (int i = 0; i < 2; ++i) { const float lo = bflo(c[k][i]), hi = bfhi(c[k][i]); s2 += lo * lo + hi * hi; }
      s1 = wave_sum(s1); s2 = wave_sum(s2);
      const float other = __shfl_xor(kv, 32);
      const float res = (lane < 32) ? (kv * cs[k] - other * sn[k]) : (other * sn[k] + kv * cs[k]);
      const unsigned pk = pk2(res, 0.f);
      kr[(size_t)t * 64 + lane] = (bf16_t)(pk & 0xffffu);
      if (lane == 0) {
        rsq[t] = rsqrtf(s1 * (1.0f / 512.0f) + EPS) * (0.07216878364870323f * LOG2E);
        rskv[t] = rsqrtf(s2 * (1.0f / 256.0f) + EPS);
      }
    }
  }
}

#define MFMA32(a, b, c) __builtin_amdgcn_mfma_f32_32x32x16_bf16((a), (b), (c), 0, 0, 0)
template <int DK, bool BAND, int MODE>
__device__ void attn_item(KP p, int e, int b, int h, int qb, unsigned char* smem) {
  constexpr int KSTR = (DK + 8) * 2, VSTR = 144, KBYTES = 64 * KSTR, VBYTES = 128 * VSTR, STAGE = KBYTES + VBYTES;
  constexpr int NKK = DK / 16, PPK = DK / 8, KP = (64 * PPK) / 512;
  const int tid = get_tid(), w = tid >> 6, lane = tid & 63, r = lane & 31, g = lane >> 5;
  const int myc = 4 * qb + (w >> 1);
  const int kt_lo = BAND ? (4 * qb - 8 > 0 ? 4 * qb - 8 : 0) : 0, kt_hi = 4 * qb + 3;
  const size_t tok0 = (size_t)b * SEQ;
  const int qpos = qb * 256 + 32 * w + r;
  const size_t qtok = tok0 + qpos;
  const bf16_t* z1 = (const bf16_t*)(p->ws + B_Z);
  const bf16_t* qA = (const bf16_t*)(p->ws + B_Q);
  const bf16_t* knA = (const bf16_t*)(p->ws + B_KN);
  const bf16_t* krr = (const bf16_t*)(p->ws + B_KR);
  const bf16_t* Vt = (const bf16_t*)(p->ws + B_VT) + (BAND ? (size_t)0 : (size_t)1024 * T) + (size_t)h * 128 * T;
  bf16_t* yb = (bf16_t*)(p->ws + (MODE ? B_H : B_Y));
  float* biasS = (float*)(smem + 2 * STAGE);

  __syncthreads();
  if (BAND) { if (tid < 257) biasS[tid] = p->in[11][((size_t)e * 8 + h) * 257 + tid] * LOG2E; }
  u32x4 kreg[KP], vreg[2];
  unsigned koff[KP], klds[KP], voff[2], vlds[2];
#pragma unroll
  for (int i = 0; i < KP; ++i) {
    int key, pc;
    if (!BAND && i == 2) { key = tid >> 3; pc = 16 + (tid & 7); koff[i] = (unsigned)(key * 64 + (tid & 7) * 8) * 2u; }
    else { const int pidx = tid + 512 * i; key = pidx >> 4; pc = pidx & 15; koff[i] = (unsigned)(key * (BAND ? 5120 : 1024) + pc * 8) * 2u; }
    const int rho = (key & ~12) | ((key & 4) << 1) | ((key & 8) >> 1);
    klds[i] = (unsigned)(rho * KSTR + pc * 16);
  }
#pragma unroll
  for (int i = 0; i < 2; ++i) {
    const int pidx = tid + 512 * i, d = pidx >> 3, pc = pidx & 7;
    voff[i] = (unsigned)(d * T + pc * 8) * 2u; vlds[i] = (unsigned)(KBYTES + d * VSTR + pc * 16);
  }
  const char* kb0 = BAND ? (const char*)(z1 + tok0 * 5120 + 2048 + h * 128) : (const char*)(knA + tok0 * 1024 + h * 128);
  const char* kb1 = (const char*)(krr + tok0 * 64);
  const char* vb0 = (const char*)(Vt + tok0);
  auto load_tile = [&](int kt) {
    const char* kb = kb0 + (size_t)kt * 64 * (BAND ? 5120 : 1024) * 2;
    const char* kr2 = kb1 + (size_t)kt * 64 * 64 * 2;
    const char* vb = vb0 + (size_t)kt * 64 * 2;
#pragma unroll
    for (int i = 0; i < KP; ++i) {
      if (!BAND && i == 2) kreg[i] = *(const u32x4*)(kr2 + koff[i]);
      else kreg[i] = *(const u32x4*)(kb + koff[i]);
    }
#pragma unroll
    for (int i = 0; i < 2; ++i) vreg[i] = *(const u32x4*)(vb + voff[i]);
  };
  auto store_tile = [&](int st) {
    unsigned char* Ks = smem + st * STAGE;
#pragma unroll
    for (int i = 0; i < KP; ++i) *(u32x4*)(Ks + klds[i]) = kreg[i];
#pragma unroll
    for (int i = 0; i < 2; ++i) *(u32x4*)(Ks + vlds[i]) = vreg[i];
  };

  load_tile(kt_lo);

  bf16x8 Qf[8];
  unsigned char* qs = smem + 2 * STAGE + w * 4096;
  if (!BAND) {
    const bf16_t* qp = qA + qtok * 1536 + h * 192 + 8 * g;
#pragma unroll
    for (int kk = 0; kk < 8; ++kk) Qf[kk] = *(const bf16x8*)(qp + 16 * kk);
    const float* cp = (const float*)(p->ws + B_COS) + qpos * 32 + 8 * g;
    const float* sp = (const float*)(p->ws + B_SIN) + qpos * 32 + 8 * g;
#pragma unroll
    for (int hf = 0; hf < 2; ++hf) {
      bf16x8 x1v = *(const bf16x8*)(qp + 16 * (8 + hf)), x2v = *(const bf16x8*)(qp + 16 * (10 + hf));
#pragma unroll
      for (int j = 0; j < 8; j += 2) {
        const float c0 = cp[16 * hf + j], s0 = sp[16 * hf + j], c1 = cp[16 * hf + j + 1], s1 = sp[16 * hf + j + 1];
        const float a0 = bf1((unsigned short)x1v[j]), b0 = bf1((unsigned short)x2v[j]), a1 = bf1((unsigned short)x1v[j + 1]), b1 = bf1((unsigned short)x2v[j + 1]);
        const unsigned o1 = pk2(a0 * c0 - b0 * s0, a1 * c1 - b1 * s1), o2 = pk2(a0 * s0 + b0 * c0, a1 * s1 + b1 * c1);
        x1v[j] = (short)(o1 & 0xffffu); x1v[j + 1] = (short)(o1 >> 16);
        x2v[j] = (short)(o2 & 0xffffu); x2v[j + 1] = (short)(o2 >> 16);
      }
      *(bf16x8*)(qs + hf * 1024 + lane * 16) = x1v; *(bf16x8*)(qs + (2 + hf) * 1024 + lane * 16) = x2v;
    }
  } else {
    const bf16_t* qp = z1 + qtok * 5120 + 1024 + h * 128 + 8 * g;
    const float qs = 0.08838834764831845f * LOG2E;
#pragma unroll
    for (int kk = 0; kk < NKK; ++kk) {
      bf16x8 v = *(const bf16x8*)(qp + 16 * kk);
#pragma unroll
      for (int j = 0; j < 8; j += 2) {
        const unsigned o = pk2(bf1((unsigned short)v[j]) * qs, bf1((unsigned short)v[j + 1]) * qs);
        v[j] = (short)(o & 0xffffu); v[j + 1] = (short)(o >> 16);
      }
      Qf[kk] = v;
    }
  }

  f32x16 O[4];
#pragma unroll
  for (int dt = 0; dt < 4; ++dt)
#pragma unroll
    for (int i = 0; i < 16; ++i) O[dt][i] = 0.f;
  float mrun = 0.f, lsum = 0.f;
  bool fresh = true;

  store_tile(0);
  __syncthreads();
  for (int kt = kt_lo; kt <= kt_hi; ++kt) {
    const int cur = (kt - kt_lo) & 1;
    if (MODE != 2 && kt < kt_hi) load_tile(kt + 1);
    const bool active = (MODE != 1) && (BAND ? (kt <= myc && kt >= myc - 8) : (kt <= myc));
    if (active) {
      const unsigned char* Ks = smem + cur * STAGE;
      const unsigned char* Vs = Ks + KBYTES;
      f32x16 S0, S1;
      {
        const float negm = -mrun;
#pragma unroll
        for (int i = 0; i < 16; ++i) { S0[i] = negm; S1[i] = negm; }
      }
      {
        bf16x8 kf[2][NKK], qr[4];
        const unsigned char* kp = Ks + r * KSTR + 16 * g;
        if (!BAND) {
#pragma unroll
          for (int j = 0; j < 4; ++j) qr[j] = *(const bf16x8*)(qs + j * 1024 + lane * 16);
        }
#pragma unroll
        for (int sub = 0; sub < 2; ++sub)
#pragma unroll
          for (int kk = 0; kk < NKK; ++kk) kf[sub][kk] = *(const bf16x8*)(kp + 32 * sub * KSTR + 32 * kk);
#pragma unroll
        for (int kk = 0; kk < NKK; ++kk) S0 = MFMA32(kf[0][kk], (kk < 8) ? Qf[kk < 8 ? kk : 0] : qr[kk >= 8 ? kk - 8 : 0], S0);
#pragma unroll
        for (int kk = 0; kk < NKK; ++kk) S1 = MFMA32(kf[1][kk], (kk < 8) ? Qf[kk < 8 ? kk : 0] : qr[kk >= 8 ? kk - 8 : 0], S1);
        constexpr int NRD = 2 * NKK + (BAND ? 0 : 4), NMM = 2 * NKK, PRE = BAND ? 5 : 9;
        __builtin_amdgcn_sched_group_barrier(0x100, PRE, 0);
#pragma unroll
        for (int i = 0; i < NRD - PRE; ++i) { __builtin_amdgcn_sched_group_barrier(0x008, 1, 0); __builtin_amdgcn_sched_group_barrier(0x100, 1, 0); }
        __builtin_amdgcn_sched_group_barrier(0x008, NMM - (NRD - PRE), 0);
      }
      if (BAND) {
        if (kt >= myc - 2) {
          const int rel0 = qpos - (kt * 64 + 8 * g);
#pragma unroll
          for (int i = 0; i < 16; ++i) {
            const int rel = rel0 - (16 * (i >> 3) + (i & 7));
            const int i0 = rel < 128 ? rel : 128, i1 = (rel - 32) < 128 ? (rel - 32) : 128;
            S0[i] += biasS[i0 + 128]; S1[i] += biasS[i1 + 128];
          }
        } else {
          const float cb = biasS[256];
#pragma unroll
          for (int i = 0; i < 16; ++i) { S0[i] += cb; S1[i] += cb; }
        }
      }
      float mx = __builtin_fmaxf(S0[0], S1[0]);
#pragma unroll
      for (int i = 1; i < 16; ++i) mx = max3f(mx, S0[i], S1[i]);
      mx = fmaxf(mx, __shfl_xor(mx, 32));
      if (__any(mx > 8.0f) || fresh) {
        const float d = fresh ? mx : fmaxf(mx, 0.f);
        const float alpha = fresh ? 1.0f : __builtin_amdgcn_exp2f(-d);
        mrun += d;
        lsum *= alpha;
#pragma unroll
        for (int dt = 0; dt < 4; ++dt)
#pragma unroll
          for (int i = 0; i < 16; ++i) O[dt][i] *= alpha;
#pragma unroll
        for (int i = 0; i < 16; ++i) { S0[i] -= d; S1[i] -= d; }
        fresh = false;
      }
      {
        bf16x8 vf[2][2][4];
        const unsigned char* vp = Vs + r * VSTR + 16 * g;
#pragma unroll
        for (int sub = 0; sub < 2; ++sub)
#pragma unroll
          for (int kb = 0; kb < 2; ++kb)
#pragma unroll
            for (int dt = 0; dt < 4; ++dt) vf[sub][kb][dt] = *(const bf16x8*)(vp + 32 * dt * VSTR + 64 * sub + 32 * kb);
        float ps = 0.f;
#pragma unroll
        for (int sub = 0; sub < 2; ++sub) {
#pragma unroll
          for (int i = 0; i < 16; ++i) {
            if (sub == 0) { S0[i] = __builtin_amdgcn_exp2f(S0[i]); ps += S0[i]; }
            else { S1[i] = __builtin_amdgcn_exp2f(S1[i]); ps += S1[i]; }
          }
#pragma unroll
          for (int kb = 0; kb < 2; ++kb) {
            u32x4 pp;
#pragma unroll
            for (int j = 0; j < 4; ++j) pp[j] = sub ? pk2(S1[8 * kb + 2 * j], S1[8 * kb + 2 * j + 1]) : pk2(S0[8 * kb + 2 * j], S0[8 * kb + 2 * j + 1]);
            const bf16x8 Pf = __builtin_bit_cast(bf16x8, pp);
#pragma unroll
            for (int dt = 0; dt < 4; ++dt) O[dt] = MFMA32(vf[sub][kb][dt], Pf, O[dt]);
          }
        }
        lsum += ps;
        __builtin_amdgcn_sched_group_barrier(0x100, 8, 0);
        __builtin_amdgcn_sched_group_barrier(0x002, 40, 0);
#pragma unroll
        for (int i = 0; i < 8; ++i) { __builtin_amdgcn_sched_group_barrier(0x008, 1, 0); __builtin_amdgcn_sched_group_barrier(0x100, 1, 0); __builtin_amdgcn_sched_group_barrier(0x002, 5, 0); }
        __builtin_amdgcn_sched_group_barrier(0x008, 8, 0);
      }
    }
    if (MODE != 2 && kt < kt_hi) store_tile(cur ^ 1);
    __syncthreads();
  }
  lsum += __shfl_xor(lsum, 32);
  const float inv = 1.0f / lsum;
  const int ocol = (BAND ? 1024 : 0) + h * 128;
  const size_t rowbase = tok0 + qb * 256 + 32 * w;
  float* stg = (float*)(smem + w * 8704);
  u32x2 gts[16];
#pragma unroll
  for (int ps2 = 0; ps2 < 2; ++ps2)
#pragma unroll
    for (int j = 0; j < 8; ++j) {
      const int idx = lane + 64 * j, row = idx >> 4, piece = idx & 15;
      gts[ps2 * 8 + j] = *(const u32x2*)(z1 + (rowbase + row) * 5120 + 3072 + ocol + 64 * ps2 + 4 * piece);
    }
#pragma unroll
  for (int ps2 = 0; ps2 < 2; ++ps2) {
#pragma unroll
    for (int dd = 0; dd < 2; ++dd)
#pragma unroll
      for (int i4 = 0; i4 < 4; ++i4) {
        const int dt = 2 * ps2 + dd;
        f32x4 v; v[0] = O[dt][4 * i4] * inv; v[1] = O[dt][4 * i4 + 1] * inv; v[2] = O[dt][4 * i4 + 2] * inv; v[3] = O[dt][4 * i4 + 3] * inv;
        *(f32x4*)(stg + r * 68 + 32 * dd + 8 * i4 + 4 * g) = v;
      }
#pragma unroll
    for (int j = 0; j < 8; ++j) {
      const int idx = lane + 64 * j, row = idx >> 4, piece = idx & 15;
      const f32x4 v = *(const f32x4*)(stg + row * 68 + 4 * piece);
      const u32x2 gt = gts[ps2 * 8 + j];
      u32x2 o;
      o[0] = pk2(v[0] * silu_f(bflo(gt[0])), v[1] * silu_f(bfhi(gt[0])));
      o[1] = pk2(v[2] * silu_f(bflo(gt[1])), v[3] * silu_f(bfhi(gt[1])));
      *(u32x2*)(yb + (rowbase + row) * 2048 + ocol + 64 * ps2 + 4 * piece) = o;
    }
  }
}

template <int MODE>
__device__ void attn_phase(KP p, int e_ctr, unsigned char* smem) {
  const int e = e_ctr & 1;
  unsigned* ctr = (unsigned*)(p->ws + B_CTR) + e_ctr;
  int* slot = (int*)(smem + 131072 - 16);
  for (;;) {
    __syncthreads();
    if (get_tid() == 0) *slot = (int)atomicAdd(ctr, 1u);
    __syncthreads();
    const int item = *slot;
    if (item >= 1024) break;
    const int grp = item >> 6, bh = item & 63, b = bh >> 3, h = bh & 7;
    int ty, qb;
    if (grp < 6) { ty = 0; qb = 7 - grp; }
    else if (grp < 12) { ty = 1; qb = 13 - grp; }
    else { ty = grp & 1; qb = (grp < 14) ? 1 : 0; }
    if (ty == 0) attn_item<192, false, MODE>(p, e, b, h, qb, smem);
    else attn_item<128, true, MODE>(p, e, b, h, qb, smem);
  }
}

__device__ void gating_phase(KP p, int o, unsigned char* smem) {
  const bf16_t* vT = (const bf16_t*)(p->ws + B_VT);
  const bf16_t* ug = (const bf16_t*)(p->ws + B_Z);
  bf16_t* yb = (bf16_t*)(p->ws + B_Y);
  const float* cst = (const float*)(p->ws + B_KR);
  unsigned char* wsS = smem;
  float* muS = (float*)(smem + 34816); float* rsS = muS + 128; float* c1S = rsS + 128; float* c2S = c1S + 128;
  const int tid = get_tid(), w = tid >> 6, lane = tid & 63, fr = lane & 15, fq = lane >> 4;
  for (int item = blockIdx.x; item < 1024; item += gridDim.x) {
    const int g = item & 7, bn = item >> 3; const size_t tok0 = (size_t)bn * 128;
    __syncthreads();
    if (tid < 128) {
      float sm = 0.f, sq = 0.f;
#pragma unroll
      for (int k = 0; k < 16; ++k) { sm += cst[(size_t)(2 * k) * T + tok0 + tid]; sq += cst[(size_t)(2 * k + 1) * T + tok0 + tid]; }
      const float m = sm * (1.0f / 2048.0f);
      const float var = sq * (1.0f / 2048.0f) - m * m;
      muS[tid] = m; rsS[tid] = rsqrtf(fmaxf(var, 0.f) + EPS);
    }
    __syncthreads();
    {
      const int i = tid >> 2, jq = tid & 3;
      const float* wrow = p->in[16] + (((size_t)o * 8 + g) * 128 + i) * 128 + 32 * jq;
      float c1 = 0.f, c2 = 0.f;
#pragma unroll
      for (int q4 = 0; q4 < 8; q4 += 2) {
        const f32x4 wa = *(const f32x4*)(wrow + 4 * q4), wb = *(const f32x4*)(wrow + 4 * q4 + 4);
        float v[8];
#pragma unroll
        for (int e2 = 0; e2 < 8; ++e2) {
          const int j = 32 * jq + 4 * q4 + e2;
          const float wm = ((j >> 6) <= (i >> 6)) ? (e2 < 4 ? wa[e2 & 3] : wb[e2 & 3]) : 0.f;
          c2 += wm; const float wsv = wm * rsS[j]; c1 += wsv * muS[j]; v[e2] = wsv;
        }
        u32x4 o4; o4[0] = pk2(v[0], v[1]); o4[1] = pk2(v[2], v[3]); o4[2] = pk2(v[4], v[5]); o4[3] = pk2(v[6], v[7]);
        *(u32x4*)(wsS + i * 272 + (32 * jq + 4 * q4) * 2) = o4;
      }
      c1 += __shfl_xor(c1, 1); c1 += __shfl_xor(c1, 2);
      c2 += __shfl_xor(c2, 1); c2 += __shfl_xor(c2, 2);
      if (jq == 0) { c1S[i] = c1; c2S[i] = c2; }
    }
    const int d0 = g * 256 + 32 * w;
    bf16x8 Af[2][4];
#pragma unroll
    for (int dt = 0; dt < 2; ++dt)
#pragma unroll
      for (int ks = 0; ks < 4; ++ks) Af[dt][ks] = *(const bf16x8*)(vT + (size_t)(d0 + 16 * dt + fr) * T + tok0 + 32 * ks + 8 * fq);
    const float* lng = p->in[14] + (size_t)o * 2048; const float* lnb = p->in[15] + (size_t)o * 2048;
    const float* bs = p->in[17] + ((size_t)o * 8 + g) * 128;
    f32x4 g4[2], b4[2];
#pragma unroll
    for (int dt = 0; dt < 2; ++dt) { g4[dt] = *(const f32x4*)(lng + d0 + 16 * dt + 4 * fq); b4[dt] = *(const f32x4*)(lnb + d0 + 16 * dt + 4 * fq); }
    __syncthreads();
#pragma unroll
    for (int hf = 0; hf < 2; ++hf) {
      u32x2 uu[4][2]; float bsv[4];
#pragma unroll
      for (int i2 = 0; i2 < 4; ++i2) {
        const size_t tok = tok0 + 16 * (4 * hf + i2) + fr;
        bsv[i2] = bs[16 * (4 * hf + i2) + fr];
#pragma unroll
        for (int dt = 0; dt < 2; ++dt) {
          const int dc = d0 + 16 * dt + 4 * fq;
          uu[i2][dt] = *(const u32x2*)(ug + tok * 2048 + dc);
        }
      }
#pragma unroll
      for (int i2 = 0; i2 < 4; ++i2) {
        const int it = 4 * hf + i2;
        f32x4 acc0 = {0.f, 0.f, 0.f, 0.f}, acc1 = {0.f, 0.f, 0.f, 0.f};
#pragma unroll
        for (int ks = 0; ks < 4; ++ks) {
          const bf16x8 Bf = *(const bf16x8*)(wsS + (16 * it + fr) * 272 + (32 * ks + 8 * fq) * 2);
          acc0 = __builtin_amdgcn_mfma_f32_16x16x32_bf16(Af[0][ks], Bf, acc0, 0, 0, 0);
          acc1 = __builtin_amdgcn_mfma_f32_16x16x32_bf16(Af[1][ks], Bf, acc1, 0, 0, 0);
        }
        const int i = 16 * it + fr; const size_t tok = tok0 + i;
        const float c1 = c1S[i], c2 = c2S[i], bsi = bsv[i2];
#pragma unroll
        for (int dt = 0; dt < 2; ++dt) {
          const f32x4 a = dt ? acc1 : acc0;
          const int dc = d0 + 16 * dt + 4 * fq;
          const u32x2 u4 = uu[i2][dt];
          const float sv0 = g4[dt][0] * (a[0] - c1) + b4[dt][0] * c2 + bsi, sv1 = g4[dt][1] * (a[1] - c1) + b4[dt][1] * c2 + bsi;
          const float sv2 = g4[dt][2] * (a[2] - c1) + b4[dt][2] * c2 + bsi, sv3 = g4[dt][3] * (a[3] - c1) + b4[dt][3] * c2 + bsi;
          u32x2 o2;
          o2[0] = pk2(bflo(u4[0]) * sv0, bfhi(u4[0]) * sv1);
          o2[1] = pk2(bflo(u4[1]) * sv2, bfhi(u4[1]) * sv3);
          *(u32x2*)(yb + tok * 2048 + dc) = o2;
        }
      }
    }
  }
  __syncthreads();
}

#define XB_TMO      128
#define XB_XCNT(j)  (256  + 64 * (j))
#define XB_XSUB(j)  (1280 + 64 * (j))
#define XB_XGEN(j)  (2304 + 64 * (j))
#define XB_TOP      3328
#define XB_TOPGEN   3392
#define XCD_BAR_WORDS 3456
#define XB_SPIN_CAP (1u << 22)
DI unsigned xb_ld(unsigned* p)              { return __hip_atomic_load(p, __ATOMIC_RELAXED, __HIP_MEMORY_SCOPE_AGENT); }
DI unsigned xb_add(unsigned* p, unsigned v) { return __hip_atomic_fetch_add(p, v, __ATOMIC_RELAXED, __HIP_MEMORY_SCOPE_AGENT); }
DI unsigned xb_xcc_id() { return (unsigned)__builtin_amdgcn_s_getreg((3 << 11) | 20) & 0xFu; }
#define XB_SPIN(cond, bar) do { unsigned _sp = 0; while (cond) { __builtin_amdgcn_s_sleep(1); \
    if ((++_sp & 255u) == 0u) { if (xb_ld(&(bar)[XB_TMO])) break; if (_sp > XB_SPIN_CAP) { atomicAdd(&(bar)[XB_TMO], 1u); break; } } } } while (0)
struct XcdBarrier { unsigned* bar; unsigned x; volatile LAS unsigned* st; };
DI XcdBarrier xcd_barrier_post(unsigned* bar, volatile LAS unsigned* st) {
  XcdBarrier b; b.bar = bar; b.x = xb_xcc_id(); b.st = st;
  if (threadIdx.x == 0) (void)xb_add(&bar[XB_XCNT(b.x)], 1u);
  return b;
}
DI void xcd_barrier_complete(unsigned* bar, unsigned x, unsigned& nloc, unsigned& nx) {
  const unsigned G = gridDim.x * gridDim.y * gridDim.z;
  unsigned sum, cnt, mine, sp = 0u;
  for (;;) {
    sum = 0u; cnt = 0u; mine = 0u;
#pragma unroll
    for (unsigned j = 0; j < 16; ++j) { const unsigned c = xb_ld(&bar[XB_XCNT(j)]); sum += c; cnt += (c > 0u) ? 1u : 0u; mine = (j == x) ? c : mine; }
    if (sum == G) break;
    __builtin_amdgcn_s_sleep(1);
    if ((++sp & 255u) == 0u) { if (xb_ld(&bar[XB_TMO])) break; if (sp > XB_SPIN_CAP) { atomicAdd(&bar[XB_TMO], 1u); break; } }
  }
  nloc = mine > 0u ? mine : 1u; nx = cnt > 0u ? cnt : 1u;
}
DI void xcd_barrier(const XcdBarrier& b) {
  asm volatile("s_waitcnt vmcnt(0)" ::: "memory");
  __syncthreads();
  if (threadIdx.x == 0) {
    unsigned* bar = b.bar;
    __builtin_amdgcn_s_waitcnt(0);
    unsigned nloc = b.st[0], nx = b.st[1];
    if (nloc == 0u) { xcd_barrier_complete(bar, b.x, nloc, nx); b.st[0] = nloc; b.st[1] = nx; }
    const unsigned old = xb_add(&bar[XB_XSUB(b.x)], 1u);
    const unsigned gen = old / nloc;
    if (old + 1u == (gen + 1u) * nloc) {
      __builtin_amdgcn_fence(__ATOMIC_RELEASE, "agent");
      asm volatile("s_waitcnt vmcnt(0)" ::: "memory");
      const unsigned og = xb_add(&bar[XB_TOP], 1u);
      const unsigned tg = og / nx;
      if (og + 1u == (tg + 1u) * nx) xb_add(&bar[XB_TOPGEN], 1u);
      else XB_SPIN(xb_ld(&bar[XB_TOPGEN]) == tg, bar);
      __builtin_amdgcn_fence(__ATOMIC_ACQUIRE, "agent");
      xb_add(&bar[XB_XGEN(b.x)], 1u);
      asm volatile("s_waitcnt vmcnt(0)" ::: "memory");
    } else {
      XB_SPIN(xb_ld(&bar[XB_XGEN(b.x)]) == gen, bar);
      __builtin_amdgcn_fence(__ATOMIC_ACQUIRE, "agent");
      asm volatile("s_waitcnt vmcnt(0)" ::: "memory");
    }
  }
  __syncthreads();
}

DI bool get_gemm(KP p, int l, int slot, int gi, GemmDesc& d) {
  const bool even = (l & 1) == 0; const int li = l >> 1;
  bf16_t* W = (bf16_t*)(p->ws + B_W);
  bf16_t* hb = (bf16_t*)(p->ws + B_H);
  bf16_t* zb = (bf16_t*)(p->ws + B_Z);
  bf16_t* vt = (bf16_t*)(p->ws + B_VT);
  bf16_t* yb = (bf16_t*)(p->ws + B_Y);
  const float* st0 = (const float*)(p->ws + B_ST0); const float* st1 = (const float*)(p->ws + B_ST1);
  const bf16_t* WL = W + (even ? (size_t)li * EVEN_SZ : 2 * EVEN_SZ + (size_t)li * ODD_SZ);
  d.rs = nullptr; d.cs = nullptr; d.cst = nullptr; d.ugmode = 0;
  if (slot == 0) {
    if (gi >= 2) return false;
    if (even) {
      if (gi == 0) { d.A = hb; d.lda = 2048; d.Bt = WL + E_WIN; d.ldb = 2048; d.M = T; d.N = 5120; d.K = 2048; d.O = zb; d.ldc = 5120; }
      else { d.A = WL + E_WBV; d.lda = 2048; d.Bt = hb; d.ldb = 2048; d.M = 1024; d.N = T; d.K = 2048; d.O = vt; d.ldc = T; }
    } else {
      if (gi == 0) { d.A = hb; d.lda = 2048; d.Bt = WL + O_WUG; d.ldb = 2048; d.M = T; d.N = 4096; d.K = 2048; d.O = zb; d.ldc = 2048; d.ugmode = 1; }
      else { d.A = WL + O_WV; d.lda = 2048; d.Bt = hb; d.ldb = 2048; d.M = 2048; d.N = T; d.K = 2048; d.O = vt; d.ldc = T; d.cst = (float*)(p->ws + B_KR); }
    }
    return true;
  }
  if (slot == 2) {
    if (gi >= 3) return false;
    if (gi == 0) { d.A = zb; d.lda = 5120; d.Bt = WL + E_WUQ; d.ldb = 512; d.M = T; d.N = 1536; d.K = 512; d.O = (bf16_t*)(p->ws + B_Q); d.ldc = 1536; d.rs = st0; }
    else if (gi == 1) { d.A = zb + 512; d.lda = 5120; d.Bt = WL + E_WKN; d.ldb = 256; d.M = T; d.N = 1024; d.K = 256; d.O = (bf16_t*)(p->ws + B_KN); d.ldc = 1024; d.rs = st1; }
    else { d.A = WL + E_WV; d.lda = 256; d.Bt = zb + 512; d.ldb = 5120; d.M = 1024; d.N = T; d.K = 256; d.O = vt + (size_t)1024 * T; d.ldc = T; d.cs = st1; }
    return true;
  }
  if (gi >= 1) return false;
  d.A = yb; d.lda = 2048; d.Bt = WL + (even ? E_WOUT : O_WOUT); d.ldb = 2048; d.M = T; d.N = 2048; d.K = 2048; d.O = zb; d.ldc = 2048;
  return true;
}

__global__ void __launch_bounds__(512, 2) mega(Params p_arg, int ph_lo, int ph_hi, int coop) {
  extern __shared__ __attribute__((aligned(16))) unsigned char smem[];
  cg::grid_group grid = cg::this_grid();
  __shared__ uint4 xb_words;
  if (threadIdx.x == 0) xb_words = make_uint4(0u, 0u, 0u, 0u);
  __syncthreads();
  const XcdBarrier xb = xcd_barrier_post((unsigned*)(p_arg.ws + B_BAR), (volatile LAS unsigned*)&xb_words);
  bool first = true;
  for (int ph = ph_lo; ph < ph_hi; ++ph) {
    int l = 0, slot = -1;
    if (ph >= 2) { l = (ph - 2) / 6; slot = (ph - 2) % 6; }
    const bool even = (l & 1) == 0; const int li = l >> 1;
    if (ph >= 2 && !even && (slot == 3 || slot == 1)) continue;
    if (!first && coop) { if (coop == 2) grid.sync(); else xcd_barrier(xb); }
    first = false;
    KP p = (KP)__builtin_amdgcn_kernarg_segment_ptr();
    asm volatile("" : "+s"(p));
    if (ph == 0) {
#pragma unroll 1
      for (int rep = 0; rep < REP_PREP; ++rep) prep_phase(p, smem);
    } else if (ph == 1 || slot == 5) {
#ifndef DIS_ROWS
      if (ph == 1) rows_phase(p, -1, 0); else rows_phase(p, l, l + 1);
#endif
    } else if (slot == 0 || slot == 4 || (slot == 2 && even)) {
#ifndef DIS_GEMM
#pragma unroll 1
      for (int gi2 = 0; gi2 < 3 * REP_GEMM; ++gi2) {
        const int gi = gi2 / REP_GEMM;
        GemmDesc d;
        if (!get_gemm(p, l, slot, gi, d)) break;
        pg8::Gemm g{d.A, d.Bt, d.M, d.N, d.K, d.lda, d.ldb};
        pg8::StaticOrder S; S.init(d.M, d.N, (int)gridDim.x, (int)blockIdx.x);
        if (slot == 2 && gi == 1 && (gridDim.x & 1) == 0 && (int)gridDim.x * 2 > (d.M / 256) * (d.N / 256)) {
          const int half = (int)gridDim.x / 2;
          if ((int)blockIdx.x >= half) S.init(d.M, d.N, half, (int)blockIdx.x - half);
          else S.init(d.M, d.N, half, 1 << 28);
        }
        pg8::gemm_phase((LAS unsigned char*)smem, g, S, pg8::EpiBf16S{d.O, d.ldc, d.rs, d.cs, d.cst, T, d.ugmode});
        __syncthreads();
      }
#endif
    } else if (slot == 1) {
#pragma unroll 1
      for (int rep = 0; rep < REP_MISC; ++rep) even_stats_phase(p);
    } else if (slot == 2) {
#pragma unroll 1
      for (int rep = 0; rep < REP_MISC; ++rep) gating_phase(p, li, smem);
    } else if (slot == 3) {
      attn_phase<0>(p, li, smem);
#if PROBE_ATTN_MODE
      attn_phase<PROBE_ATTN_MODE>(p, li + 2, smem);
#endif
    }
  }
}

extern "C" void kernel_launch(void* const* d_in, const int* in_sizes, int n_in, void* d_out, int out_size, void* d_ws, size_t ws_size, hipStream_t stream) {
  constexpr size_t kDynLds = 131072;
  static int grid_blocks = 0;
  if (!grid_blocks) {
    (void)hipFuncSetAttribute((const void*)mega, hipFuncAttributeMaxDynamicSharedMemorySize, (int)kDynLds);
    int dev = 0, cus = 0, per_cu = 0;
    (void)hipGetDevice(&dev);
    (void)hipDeviceGetAttribute(&cus, hipDeviceAttributeMultiprocessorCount, dev);
    (void)hipOccupancyMaxActiveBlocksPerMultiprocessor(&per_cu, mega, 512, kDynLds);
    if (per_cu < 1) fprintf(stderr, "occupancy query returned %d\n", per_cu);
    grid_blocks = cus;
    if (ws_size < WS_NEED) fprintf(stderr, "workspace too small: %zu < %zu\n", ws_size, (size_t)WS_NEED);
  }
  Params p{};
  for (int i = 0; i < 19; ++i) p.in[i] = (const float*)d_in[i];
  p.out = (float*)d_out; p.ws = (unsigned char*)d_ws;
  (void)hipMemsetAsync((unsigned char*)d_ws + B_BAR, 0, ZERO_BYTES, stream);
  int ph_lo = 0, ph_hi = 26, coop = 1;
  void* args[] = {&p, &ph_lo, &ph_hi, &coop};
  hipError_t e = hipLaunchCooperativeKernel((void*)mega, dim3(grid_blocks), dim3(512), args, kDynLds, stream);
  if (e != hipSuccess) fprintf(stderr, "cooperative launch failed: %s (grid %d)\n", hipGetErrorString(e), grid_blocks);
}
```
